# Optimizing an MI355X kernel written in HIP

```python
import jax, jax.numpy as jnp
from jax import lax
import numpy as np

D_MODEL = 1024
BATCH = 2
SEQ = 8192
DEPTH = 1

MEM_LEN = 256
EPS = 1e-6
POOL_WINDOWS = (2, 4, 8, 16)
POOL_GROUP = 128
POOL_WIDTH = POOL_GROUP * len(POOL_WINDOWS)
NSA_HEADS = 16
NSA_KV_GROUPS = 2
HEAD_DIM = 64
NSA_WIDTH = NSA_HEADS * HEAD_DIM
NSA_KV_WIDTH = NSA_KV_GROUPS * HEAD_DIM
CMP_BLOCK = 32
CMP_STRIDE = 16
CMP_HIDDEN = 256
SEL_BLOCK = 64
SEL_TOPK = 16
WINDOW = 512
Q_BLOCK = 128
ROPE_THETA = 500000.0
ROT_DIM = HEAD_DIM // 4
XA_HEADS = 4
XA_HEAD_DIM = 128
XA_WIDTH = XA_HEADS * XA_HEAD_DIM
N_BRANCHES = 3
D_FF = 2816
CONV_WIDTH = 3
IN_SIZES = (POOL_WIDTH, NSA_WIDTH, 6 * NSA_KV_WIDTH, 3 * NSA_HEADS, XA_WIDTH, N_BRANCHES * D_MODEL)
D_IN = POOL_WIDTH + NSA_WIDTH + 6 * NSA_KV_WIDTH + 3 * NSA_HEADS + XA_WIDTH + N_BRANCHES * D_MODEL

kernel_name = 'hybrid_pool_nsa_memory_block'


def rmsnorm(x, g):
    xf = x.astype(jnp.float32)
    y = xf * lax.rsqrt(jnp.mean(xf * xf, axis=-1, keepdims=True) + EPS)
    return (y * g.astype(jnp.float32)).astype(x.dtype)


def rotary(x, pos):
    half = ROT_DIM // 2
    inv_freq = ROPE_THETA ** (-jnp.arange(half, dtype=jnp.float32) * (2.0 / ROT_DIM))
    ang = pos.astype(jnp.float32)[..., None] * inv_freq
    cos = jnp.cos(ang)[:, :, None, :]
    sin = jnp.sin(ang)[:, :, None, :]
    xr = x[..., :ROT_DIM].astype(jnp.float32)
    x1, x2 = xr[..., :half], xr[..., half:]
    rot = jnp.concatenate([x1 * cos - x2 * sin, x2 * cos + x1 * sin], axis=-1).astype(x.dtype)
    return jnp.concatenate([rot, x[..., ROT_DIM:]], axis=-1)


def masked_softmax(s, mask):
    s = jnp.where(mask, s, -jnp.inf)
    m = jnp.max(s, axis=-1, keepdims=True)
    m = jnp.where(jnp.isfinite(m), m, 0.0)
    p = jnp.where(mask, jnp.exp(s - m), 0.0)
    return p / jnp.maximum(jnp.sum(p, axis=-1, keepdims=True), jnp.finfo(jnp.float32).tiny)


def multiscale_pool(u, pool_w, pool_scale):
    B, S, _ = u.shape
    uf = u.astype(jnp.float32)
    cs = jnp.concatenate([jnp.zeros((B, 1, POOL_WIDTH), jnp.float32), jnp.cumsum(uf, axis=1)], axis=1)
    t = jnp.arange(S)
    outs = []
    for gi, w in enumerate(POOL_WINDOWS):
        c = cs[:, :, gi * POOL_GROUP:(gi + 1) * POOL_GROUP]
        start = jnp.maximum(t + 1 - w, 0)
        cnt = (t + 1 - start).astype(jnp.float32)
        outs.append((c[:, 1:] - c[:, start]) / cnt[None, :, None] - uf[:, :, gi * POOL_GROUP:(gi + 1) * POOL_GROUP])
    p = jnp.stack(outs, axis=2).astype(u.dtype)
    y = jnp.einsum('bsgc,gcd->bsgd', p, pool_w).reshape(B, S, POOL_WIDTH)
    return y * pool_scale


def compress(kv, pe, w1, w2):
    B, S = kv.shape[:2]
    n_cmp = (S - CMP_BLOCK) // CMP_STRIDE + 1
    idx = jnp.arange(n_cmp)[:, None] * CMP_STRIDE + jnp.arange(CMP_BLOCK)[None, :]
    blk = kv[:, idx] + pe[None, None, :, None, :]
    blk = blk.transpose(0, 1, 3, 2, 4).reshape(B, n_cmp, NSA_KV_GROUPS, CMP_BLOCK * HEAD_DIM)
    return jax.nn.gelu(blk @ w1, approximate=True) @ w2


def nsa_attention(q, k_cmp, v_cmp, k_sel, v_sel, k_win, v_win, gates):
    B, S = q.shape[:2]
    G, HG = NSA_KV_GROUPS, NSA_HEADS // NSA_KV_GROUPS
    n_cmp = k_cmp.shape[1]
    n_sel = S // SEL_BLOCK
    top = min(SEL_TOPK, n_sel)
    nb = S // Q_BLOCK
    cmp_start = jnp.arange(n_cmp) * CMP_STRIDE
    cmp_end = cmp_start + CMP_BLOCK - 1
    sel_start = jnp.arange(n_sel) * SEL_BLOCK
    overlap = ((cmp_start[:, None] < sel_start[None, :] + SEL_BLOCK)
               & (cmp_start[:, None] + CMP_BLOCK > sel_start[None, :])).astype(jnp.float32)
    ks_blocks = k_sel.reshape(B, n_sel, SEL_BLOCK, G, HEAD_DIM).transpose(0, 3, 1, 2, 4)
    vs_blocks = v_sel.reshape(B, n_sel, SEL_BLOCK, G, HEAD_DIM).transpose(0, 3, 1, 2, 4)
    pad = ((0, 0), (WINDOW, 0), (0, 0), (0, 0))
    kw_pad = jnp.pad(k_win, pad)
    vw_pad = jnp.pad(v_win, pad)
    gather = jax.vmap(jax.vmap(lambda blocks, ix: blocks[ix]))
    blk_ids = jnp.arange(n_sel)[None, :]

    def block_fn(args):
        qb, gb, jb = args
        qb = qb.reshape(B, Q_BLOCK, G, HG, HEAD_DIM)
        tq = jb * Q_BLOCK + jnp.arange(Q_BLOCK)
        s_c = jnp.einsum('bqghd,bcgd->bghqc', qb, k_cmp).astype(jnp.float32)
        p_c = masked_softmax(s_c, cmp_end[None, :] <= tq[:, None])
        o_c = jnp.einsum('bghqc,bcgd->bqghd', p_c.astype(v_cmp.dtype), v_cmp)
        imp = jnp.einsum('bghqc,cj->bgqj', p_c, overlap)
        cur = (tq // SEL_BLOCK)[:, None]
        forced = (blk_ids == 0) | (blk_ids == cur) | (blk_ids == cur - 1)
        imp = jnp.where(blk_ids > cur, -jnp.inf, jnp.where(forced, jnp.inf, imp))
        _, idx = lax.top_k(imp, top)
        k_g = gather(ks_blocks, idx).reshape(B, G, Q_BLOCK, top * SEL_BLOCK, HEAD_DIM)
        v_g = gather(vs_blocks, idx).reshape(B, G, Q_BLOCK, top * SEL_BLOCK, HEAD_DIM)
        kpos = (idx[..., None] * SEL_BLOCK + jnp.arange(SEL_BLOCK)).reshape(B, G, Q_BLOCK, top * SEL_BLOCK)
        s_s = jnp.einsum('bqghd,bgqkd->bghqk', qb, k_g).astype(jnp.float32)
        p_s = masked_softmax(s_s, (kpos <= tq[None, None, :, None])[:, :, None])
        o_s = jnp.einsum('bghqk,bgqkd->bqghd', p_s.astype(v_g.dtype), v_g)
        k_w = lax.dynamic_slice_in_dim(kw_pad, jb * Q_BLOCK, WINDOW + Q_BLOCK, axis=1)
        v_w = lax.dynamic_slice_in_dim(vw_pad, jb * Q_BLOCK, WINDOW + Q_BLOCK, axis=1)
        kidx = jb * Q_BLOCK - WINDOW + jnp.arange(WINDOW + Q_BLOCK)
        diff = tq[:, None] - kidx[None, :]
        s_w = jnp.einsum('bqghd,bkgd->bghqk', qb, k_w).astype(jnp.float32)
        p_w = masked_softmax(s_w, (kidx[None, :] >= 0) & (diff >= 0) & (diff < WINDOW))
        o_w = jnp.einsum('bghqk,bkgd->bqghd', p_w.astype(v_w.dtype), v_w)
        gb = gb.reshape(B, Q_BLOCK, G, HG, 3)
        o = gb[..., 0:1] * o_c + gb[..., 1:2] * o_s + gb[..., 2:3] * o_w
        return o.reshape(B, Q_BLOCK, NSA_WIDTH)

    qs = q.reshape(B, nb, Q_BLOCK, NSA_HEADS, HEAD_DIM).swapaxes(0, 1)
    gs = gates.reshape(B, nb, Q_BLOCK, NSA_HEADS, 3).swapaxes(0, 1)
    out = lax.map(block_fn, (qs, gs, jnp.arange(nb)))
    return out.swapaxes(0, 1).reshape(B, S, NSA_WIDTH)


def memory_attention(q, mem_n, w_mem_kv):
    B, M, _ = mem_n.shape
    kv = (mem_n @ w_mem_kv).reshape(B, M, 2, XA_HEADS, XA_HEAD_DIM)
    k, v = kv[:, :, 0], kv[:, :, 1]
    s = jnp.einsum('bshd,bmhd->bhsm', q, k).astype(jnp.float32) * (XA_HEAD_DIM ** -0.5)
    p = jax.nn.softmax(s, axis=-1).astype(v.dtype)
    return jnp.einsum('bhsm,bmhd->bshd', p, v).reshape(B, q.shape[1], XA_WIDTH)


def hybrid_mixer(h, mem, positions, w_in, pool_w, pool_scale, cmp_pe, cmp_w1, cmp_w2, mem_norm_g,
                 w_mem_kv, w_br_pool, w_br_nsa, w_br_xa, w_out):
    B, S, _ = h.shape
    z = h @ w_in
    u_pool, q, kv, g_nsa, q_x, g_br = jnp.split(z, np.cumsum(IN_SIZES)[:-1].tolist(), axis=-1)
    y_pool = multiscale_pool(u_pool, pool_w, pool_scale)
    q = rotary(q.reshape(B, S, NSA_HEADS, HEAD_DIM), positions) * (HEAD_DIM ** -0.5)
    kv = kv.reshape(B, S, 6, NSA_KV_GROUPS, HEAD_DIM)
    k_c = rotary(kv[:, :, 0], positions)
    k_s = rotary(kv[:, :, 2], positions)
    k_w = rotary(kv[:, :, 4], positions)
    kc = compress(k_c, cmp_pe[0], cmp_w1[0], cmp_w2[0])
    vc = compress(kv[:, :, 1], cmp_pe[1], cmp_w1[1], cmp_w2[1])
    nsa_gates = jax.nn.sigmoid(g_nsa.reshape(B, S, NSA_HEADS, 3))
    y_nsa = nsa_attention(q, kc, vc, k_s, kv[:, :, 3], k_w, kv[:, :, 5], nsa_gates)
    y_mem = memory_attention(q_x.reshape(B, S, XA_HEADS, XA_HEAD_DIM), rmsnorm(mem, mem_norm_g), w_mem_kv)
    g = jax.nn.sigmoid(g_br.reshape(B, S, N_BRANCHES, D_MODEL))
    y = g[:, :, 0] * (y_pool @ w_br_pool) + g[:, :, 1] * (y_nsa @ w_br_nsa) + g[:, :, 2] * (y_mem @ w_br_xa)
    return y @ w_out


def conv_ffn(h, w_up, conv_w, conv_b, w_down):
    S = h.shape[1]
    u = h @ w_up
    up = jnp.pad(u, ((0, 0), (CONV_WIDTH - 1, 0), (0, 0)))
    c = conv_b
    for k in range(CONV_WIDTH):
        c = c + conv_w[k] * up[:, k:k + S]
    gate, val = jnp.split(c, 2, axis=-1)
    return (jax.nn.gelu(gate, approximate=True) * val) @ w_down


def setup_inputs(seed: int = 0) -> dict:
    key = jax.random.key(seed)
    ks = jax.random.split(key, 24)
    f32 = jnp.float32

    def nrm(k, shape, scale):
        return jax.random.normal(k, shape, f32) * scale

    def gain(k, shape):
        return 1.0 + 0.05 * jax.random.normal(k, shape, f32)

    L = DEPTH
    x = nrm(ks[0], (BATCH, SEQ, D_MODEL), 1.0)
    mem = nrm(ks[1], (BATCH, MEM_LEN, D_MODEL), 1.0)
    offset = jax.random.randint(ks[2], (BATCH, 1), 0, 4096, dtype=jnp.int32)
    positions = (offset + jnp.arange(SEQ, dtype=jnp.int32)[None, :]).astype(jnp.int32)
    return {
        'x': x,
        'mem': mem,
        'positions': positions,
        'pre_mix_g': gain(ks[3], (L, D_MODEL)),
        'w_in': nrm(ks[4], (L, D_MODEL, D_IN), D_MODEL ** -0.5),
        'pool_w': nrm(ks[5], (L, len(POOL_WINDOWS), POOL_GROUP, POOL_GROUP), POOL_GROUP ** -0.5),
        'pool_scale': 1.0 + 0.1 * jax.random.normal(ks[6], (L, POOL_WIDTH), f32),
        'cmp_pe': nrm(ks[7], (L, 2, CMP_BLOCK, HEAD_DIM), 0.1),
        'cmp_w1': nrm(ks[8], (L, 2, CMP_BLOCK * HEAD_DIM, CMP_HIDDEN), (CMP_BLOCK * HEAD_DIM) ** -0.5),
        'cmp_w2': nrm(ks[9], (L, 2, CMP_HIDDEN, HEAD_DIM), CMP_HIDDEN ** -0.5),
        'mem_norm_g': gain(ks[10], (L, D_MODEL)),
        'w_mem_kv': nrm(ks[11], (L, D_MODEL, 2 * XA_WIDTH), D_MODEL ** -0.5),
        'w_br_pool': nrm(ks[12], (L, POOL_WIDTH, D_MODEL), POOL_WIDTH ** -0.5),
        'w_br_nsa': nrm(ks[13], (L, NSA_WIDTH, D_MODEL), NSA_WIDTH ** -0.5),
        'w_br_xa': nrm(ks[14], (L, XA_WIDTH, D_MODEL), XA_WIDTH ** -0.5),
        'w_out': nrm(ks[15], (L, D_MODEL, D_MODEL), D_MODEL ** -0.5),
        'post_mix_g': gain(ks[16], (L, D_MODEL)),
        'pre_ffn_g': gain(ks[17], (L, D_MODEL)),
        'w_up': nrm(ks[18], (L, D_MODEL, 2 * D_FF), D_MODEL ** -0.5),
        'conv_w': nrm(ks[19], (L, CONV_WIDTH, 2 * D_FF), CONV_WIDTH ** -0.5),
        'conv_b': nrm(ks[20], (L, 2 * D_FF), 0.01),
        'w_down': nrm(ks[21], (L, D_FF, D_MODEL), D_FF ** -0.5),
        'post_ffn_g': gain(ks[22], (L, D_MODEL)),
    }


def reference(x, mem, positions, pre_mix_g, w_in, pool_w, pool_scale, cmp_pe, cmp_w1, cmp_w2,
              mem_norm_g, w_mem_kv, w_br_pool, w_br_nsa, w_br_xa, w_out, post_mix_g, pre_ffn_g,
              w_up, conv_w, conv_b, w_down, post_ffn_g):
    for l in range(DEPTH):
        y = hybrid_mixer(rmsnorm(x, pre_mix_g[l]), mem, positions, w_in[l], pool_w[l], pool_scale[l],
                         cmp_pe[l], cmp_w1[l], cmp_w2[l], mem_norm_g[l], w_mem_kv[l],
                         w_br_pool[l], w_br_nsa[l], w_br_xa[l], w_out[l])
        x = x + rmsnorm(y, post_mix_g[l])
        f = conv_ffn(rmsnorm(x, pre_ffn_g[l]), w_up[l], conv_w[l], conv_b[l], w_down[l])
        x = x + rmsnorm(f, post_ffn_g[l])
    return x
```

```cpp
#include <hip/hip_runtime.h>
#include <cstdio>
#include <cstdint>
#include <cmath>

#ifndef MK_LAUNCHES
#define MK_LAUNCHES 1
#endif

#define LAS __attribute__((address_space(3)))
#define GAS __attribute__((address_space(1)))
typedef unsigned short bf16;
typedef short bf16x8 __attribute__((ext_vector_type(8)));
typedef float f32x4 __attribute__((ext_vector_type(4)));
typedef float f32x16 __attribute__((ext_vector_type(16)));
typedef unsigned u32x4 __attribute__((ext_vector_type(4)));
typedef unsigned u32x2 __attribute__((ext_vector_type(2)));
typedef float f32x2_t __attribute__((ext_vector_type(2)));
typedef __bf16 bf16x2_t __attribute__((ext_vector_type(2)));

constexpr int BATCH = 2, SEQ = 8192, DM = 1024, MTOK = BATCH * SEQ;
constexpr int DIN = 5936, DINP = 6144;
constexpr int DFF = 2816, DFF2 = 5632;
constexpr float EPS = 1e-6f;
constexpr float LOG2E = 1.4426950408889634f;
constexpr float QSCALE = 0.125f * LOG2E;
constexpr float QXSCALE = 0.08838834764831845f * LOG2E;

constexpr size_t MiB = 1u << 20;
constexpr size_t WS_CTL = 0, CTL_ZERO_BYTES = 1 * MiB;
constexpr size_t WS_ROPE = 1 * MiB;
constexpr size_t WS_BIAS1 = 2 * MiB;
constexpr size_t WS_B1PART = 2 * MiB + 16 * 1024;
constexpr size_t WS_WC2T = 2 * MiB + 64 * 1024;
constexpr size_t WS_KC = 2 * MiB + 256 * 1024;
constexpr size_t WS_VCT = 2 * MiB + 512 * 1024;
constexpr size_t WS_MEMN = 3 * MiB;
constexpr size_t WS_MEMK = 4 * MiB;
constexpr size_t WS_MEMVT = 4 * MiB + 512 * 1024;
constexpr size_t WS_HID = 5 * MiB;
constexpr size_t WS_GNSA = 7 * MiB;
constexpr size_t WS_WCAT = 12 * MiB;
constexpr size_t WS_WOUT = 16 * MiB;
constexpr size_t WS_WUP = 18 * MiB;
constexpr size_t WS_WDOWN = 29 * MiB;
constexpr size_t WS_WMEM = 35 * MiB;
constexpr size_t WS_WC1 = 37 * MiB;
constexpr size_t WS_WIN = 39 * MiB;
constexpr size_t WS_KV = 51 * MiB;
constexpr size_t WS_Y = 39 * MiB;
constexpr size_t WS_F = 39 * MiB;
constexpr size_t WS_ACAT = 75 * MiB;
constexpr size_t WS_GBR = 139 * MiB;
constexpr size_t WS_A2 = 139 * MiB;
constexpr size_t WS_HALO = 227 * MiB;
constexpr size_t WS_END = 240 * MiB;
constexpr size_t KVSLAB = 2097152;

constexpr int CW_TMO = 0, CW_CODE = 1, CW_BAR = 4096;

constexpr int RING_BYTES = 131072;
constexpr int LDSCTL_OFF = RING_BYTES, MISC_OFF = LDSCTL_OFF + 320;
constexpr int LDS_BYTES = 147456;
constexpr int L_KB = 0, L_VB = 9216, L_IMP = 19456, L_SEL = 52480, L_SELCNT = 56576, L_YT = 56832;
constexpr int YT_STRIDE = 1040;
constexpr int IMP_STRIDE = 129;

__device__ __forceinline__ unsigned cvtpk(float lo, float hi) { f32x2_t v = {lo, hi}; bf16x2_t b = __builtin_convertvector(v, bf16x2_t); return __builtin_bit_cast(unsigned, b); }
__device__ __forceinline__ float bf2f(unsigned short b) { return __uint_as_float((unsigned)b << 16); }
__device__ __forceinline__ float bflo(unsigned w) { return __uint_as_float(w << 16); }
__device__ __forceinline__ float bfhi(unsigned w) { return __uint_as_float(w & 0xffff0000u); }
__device__ __forceinline__ unsigned short f2bf(float f) { return (unsigned short)(cvtpk(f, 0.f) & 0xffffu); }
__device__ __forceinline__ float wave_sum(float v) {
#pragma unroll
    for (int o = 1; o < 64; o <<= 1) v += __shfl_xor(v, o);
    return v;
}
__device__ __forceinline__ float sigmoidf_(float x) { return 1.0f / (1.0f + __builtin_amdgcn_exp2f(-x * LOG2E)); }
__device__ __forceinline__ float gelu_tanh(float x) {
    const float u2 = 1.5957691216057308f * (x + 0.044715f * x * x * x);
    return x / (1.0f + __builtin_amdgcn_exp2f(-u2 * LOG2E));
}
#define LDS_WAIT() asm volatile("s_waitcnt lgkmcnt(0)" ::: "memory")
#define VM_WAIT() asm volatile("s_waitcnt vmcnt(0)" ::: "memory")

namespace pg8 {
constexpr int BM = 256, BK = 64, HALF = 128, HTB = HALF * BK * 2, STAGE_BYTES = 8 * HTB, NXCD = 8, WGM = 8;
__host__ __device__ __forceinline__ int lds_byte(int r, int c) { const int st = (r >> 4) * 2 + (c >> 5), rr = r & 15, cc = c & 31, ob = rr * 64 + cc * 2; return st * 1024 + (ob ^ (((ob >> 9) & 1) << 5)); }
__host__ __device__ __forceinline__ void stage_rc(int b, int& R, int& C) { const int st = b / 1024, sb = b % 1024, swz = sb ^ (((sb >> 9) & 1) << 5); R = (st >> 1) * 16 + swz / 64; C = (st & 1) * 32 + (swz % 64) / 2; }
__host__ __device__ __forceinline__ int perm32(int rho) { const int n = rho >> 4, i = rho & 15; return 8 * (i >> 2) + 4 * n + (i & 3); }

struct Unit { int pm, pn, koff, nt, tag, boff; };
struct Gemm { const bf16* A; const bf16* Bt; int lda, ldb; };

__device__ __forceinline__ void tile_of(int wgid_in, int nM, int nN, int& pm, int& pn) {
    const int nwg = nM * nN; int wgid = wgid_in;
    { const int q = nwg / NXCD, r = nwg % NXCD, xcd = wgid % NXCD, off = wgid / NXCD; wgid = (xcd < r ? xcd * (q + 1) : r * (q + 1) + (xcd - r) * q) + off; }
    const int nig = WGM * nN, gid = wgid / nig, fm = gid * WGM, gsz = (nM - fm) < WGM ? (nM - fm) : WGM;
    pm = fm + ((wgid % nig) % gsz); pn = (wgid % nig) / gsz;
}
struct SchedGrid {
    int nM, nN, G, c, nt;
    __device__ __forceinline__ bool next(int i, Unit& u) const {
        const long L = (long)i * G + c; if (L >= (long)nM * nN) return false;
        tile_of((int)L, nM, nN, u.pm, u.pn); u.koff = 0; u.nt = nt; u.tag = 0; u.boff = 0; return true;
    }
};
struct SchedCat {
    int G, c;
    __device__ __forceinline__ bool next(int i, Unit& u) const {
        const int br = i % 3; const long L = (long)(i / 3) * G + c; if (L >= 256) return false;
        tile_of((int)L, 64, 4, u.pm, u.pn); u.koff = br == 0 ? 0 : (br == 1 ? 512 : 1536); u.nt = br == 1 ? 16 : 8; u.tag = br; u.boff = 0; return true;
    }
};
struct SchedCmp {
    int G, c;
    __device__ __forceinline__ bool next(int i, Unit& u) const {
        const long L = (long)i * G + c; if (L >= 16) return false;
        u.pm = (int)L; u.pn = 0; u.koff = 0; u.nt = 32; u.tag = u.pm >> 3; u.boff = u.tag * 256 * 2048; return true;
    }
};

#define PG8_SA(b, h) (((b) * 2 + (h)) * HTB)
#define PG8_SB(b, h) ((4 + (b) * 2 + (h)) * HTB)
#define PG8_STAGE(bufoff, gbase, voff) do { _Pragma("unroll") for (int _i = 0; _i < 2; ++_i) \
        __builtin_amdgcn_global_load_lds((const unsigned*)((const char*)(gbase) + (voff)[_i]), (LAS unsigned*)(lds + (bufoff) + ldsw + _i * 8192), 16, 0, 0); } while (0)
#define PG8_LDA(dst, b, h) do { _Pragma("unroll") for (int m = 0; m < 4; ++m) _Pragma("unroll") for (int k = 0; k < 2; ++k) dst[m][k] = *(const LAS bf16x8*)(lds + PG8_SA(b, h) + aoff + m * 2048 + k * 1024); } while (0)
#define PG8_LDB(dst, b, h) do { _Pragma("unroll") for (int n = 0; n < 2; ++n) _Pragma("unroll") for (int k = 0; k < 2; ++k) dst[n][k] = *(const LAS bf16x8*)(lds + PG8_SB(b, h) + boff + n * 2048 + k * 1024); } while (0)
#define PG8_MMA(ai, bj, At, Bt) do { __builtin_amdgcn_s_setprio(1); _Pragma("unroll") for (int m = 0; m < 4; ++m) _Pragma("unroll") for (int n = 0; n < 2; ++n) _Pragma("unroll") for (int k = 0; k < 2; ++k) \
        acc[ai][bj][m][n] = __builtin_amdgcn_mfma_f32_16x16x32_bf16(Bt[n][k], At[m][k], acc[ai][bj][m][n], 0, 0, 0); __builtin_amdgcn_s_setprio(0); } while (0)
#define PG8_WAIT_V(n) asm volatile("s_waitcnt vmcnt(" #n ")" ::: "memory")
#define PG8_WAIT_L(n) asm volatile("s_waitcnt lgkmcnt(" #n ")" ::: "memory")
#define PG8_BAR __builtin_amdgcn_s_barrier()
#define PG8_SCHED __builtin_amdgcn_sched_barrier(0)

template <class Epi, class Sched, bool ALIGN_EPI>
__device__ __forceinline__ void gemm_phase(LAS unsigned char* lds, const Gemm g, const Sched& S, const Epi& E) {
    const int tid = threadIdx.x, wid = __builtin_amdgcn_readfirstlane(tid >> 6), lane = tid & 63, wr = wid >> 2, wc = wid & 3, fr = lane & 15, fq = lane >> 4;
    unsigned voffA[2], voffB[2];
#pragma unroll
    for (int i = 0; i < 2; ++i) { int R, C; stage_rc(tid * 16 + i * 8192, R, C); const int Rb = Epi::PERM ? ((R & ~31) + perm32(R & 31)) : R;
        voffA[i] = (unsigned)(R * g.lda + C) * 2u; voffB[i] = (unsigned)(Rb * g.ldb + C) * 2u; }
    const size_t kstep = (size_t)(BK * 2);
    const size_t hstepA = (size_t)HALF * g.lda * 2, hstepB = (size_t)HALF * g.ldb * 2;
    const unsigned ldsw = (unsigned)wid * 1024u;
    const int aoff = lds_byte(wr * 64 + fr, fq * 8), boff = lds_byte(wc * 32 + fr, fq * 8);
    Unit cur, nxt; int ui = 0;
    if (!S.next(0, cur)) return;
    f32x4 acc[2][2][4][2];
#pragma unroll
    for (int a = 0; a < 2; ++a)
#pragma unroll
        for (int b = 0; b < 2; ++b)
#pragma unroll
            for (int m = 0; m < 4; ++m)
#pragma unroll
                for (int n = 0; n < 2; ++n) acc[a][b][m][n] = (f32x4){0.f, 0.f, 0.f, 0.f};
    bf16x8 At[4][2], B0[2][2], B1[2][2];
    const char* cA = (const char*)g.A + ((size_t)cur.pm * 256 * g.lda + cur.koff) * 2;
    const char* cB = (const char*)g.Bt + ((size_t)cur.boff + (size_t)cur.pn * 256 * g.ldb + cur.koff) * 2;
    int nt = cur.nt;
    PG8_STAGE(PG8_SB(0, 0), cB, voffB); PG8_STAGE(PG8_SB(0, 1), cB + hstepB, voffB); PG8_STAGE(PG8_SA(0, 0), cA, voffA); PG8_STAGE(PG8_SA(0, 1), cA + hstepA, voffA);
    if (wr == 1) PG8_BAR;
    PG8_WAIT_V(2); PG8_BAR;
    PG8_STAGE(PG8_SB(1, 0), cB + kstep, voffB); PG8_STAGE(PG8_SA(1, 0), cA + kstep, voffA); PG8_STAGE(PG8_SB(1, 1), cB + hstepB + kstep, voffB);
    PG8_WAIT_V(6); PG8_BAR;
    for (;;) {
        const bool has_next = S.next(ui + 1, nxt);
        const char* nA = has_next ? (const char*)g.A + ((size_t)nxt.pm * 256 * g.lda + nxt.koff) * 2 : cA;
        const char* nB = has_next ? (const char*)g.Bt + ((size_t)nxt.boff + (size_t)nxt.pn * 256 * g.ldb + nxt.koff) * 2 : cB;
        for (int t = 0; t < nt; t += 2) {
            const bool last = (t == nt - 2);
            const char* a1 = cA + (size_t)(t + 1) * kstep;
            const char* a2 = last ? nA : cA + (size_t)(t + 2) * kstep; const char* b2 = last ? nB : cB + (size_t)(t + 2) * kstep;
            const char* a3 = a2 + kstep; const char* b3 = b2 + kstep;
            PG8_LDB(B0, 0, 0); PG8_LDB(B1, 0, 1); PG8_SCHED; PG8_LDA(At, 0, 0); PG8_STAGE(PG8_SA(1, 1), a1 + hstepA, voffA);
            PG8_WAIT_V(8); PG8_WAIT_L(0); PG8_BAR; PG8_MMA(0, 0, At, B0); PG8_MMA(0, 1, At, B1); PG8_BAR; PG8_SCHED;
            PG8_LDA(At, 0, 1); PG8_STAGE(PG8_SB(0, 0), b2, voffB); PG8_STAGE(PG8_SB(0, 1), b2 + hstepB, voffB); PG8_STAGE(PG8_SA(0, 0), a2, voffA);
            PG8_WAIT_V(8); PG8_WAIT_L(0); PG8_BAR; PG8_MMA(1, 0, At, B0); PG8_MMA(1, 1, At, B1); PG8_BAR; PG8_SCHED;
            PG8_LDB(B0, 1, 0); PG8_LDB(B1, 1, 1); PG8_SCHED; PG8_LDA(At, 1, 0); PG8_STAGE(PG8_SA(0, 1), a2 + hstepA, voffA);
            PG8_WAIT_V(8); PG8_WAIT_L(0); PG8_BAR; PG8_MMA(0, 0, At, B0); PG8_MMA(0, 1, At, B1); PG8_BAR; PG8_SCHED;
            PG8_LDA(At, 1, 1); PG8_STAGE(PG8_SB(1, 0), b3, voffB); PG8_STAGE(PG8_SB(1, 1), b3 + hstepB, voffB); PG8_STAGE(PG8_SA(1, 0), a3, voffA);
            PG8_WAIT_V(8); PG8_WAIT_L(0); PG8_BAR; PG8_MMA(1, 0, At, B0); PG8_MMA(1, 1, At, B1); PG8_BAR; PG8_SCHED;
        }
        if constexpr (ALIGN_EPI) { if (wr == 0) PG8_BAR; }
        E(acc, cur, wr, wc, fr, fq);
        if (!has_next) break;
#pragma unroll
        for (int a = 0; a < 2; ++a)
#pragma unroll
            for (int b = 0; b < 2; ++b)
#pragma unroll
                for (int m = 0; m < 4; ++m)
#pragma unroll
                    for (int n = 0; n < 2; ++n) acc[a][b][m][n] = (f32x4){0.f, 0.f, 0.f, 0.f};
        cur = nxt; cA = nA; cB = nB; nt = cur.nt; ++ui;
        if constexpr (ALIGN_EPI) { if (wr == 1) PG8_BAR; }
    }
    PG8_WAIT_V(0);
    if constexpr (!ALIGN_EPI) { if (wr == 0) PG8_BAR; }
    PG8_BAR;
}

struct EpiF32 {
    static constexpr bool PERM = false;
    float* C; int ldc;
    __device__ __forceinline__ void operator()(const f32x4 (&acc)[2][2][4][2], const Unit& u, int wr, int wc, int fr, int fq) const {
        const int row0 = u.pm * BM + wr * 64 + fr, col0 = u.pn * BM + wc * 32 + 4 * fq;
#pragma unroll
        for (int ai = 0; ai < 2; ++ai)
#pragma unroll
            for (int m = 0; m < 4; ++m) { float* rowp = C + (size_t)(row0 + ai * HALF + m * 16) * ldc + col0;
#pragma unroll
                for (int bj = 0; bj < 2; ++bj)
#pragma unroll
                    for (int n = 0; n < 2; ++n) *(f32x4*)(rowp + bj * HALF + n * 16) = acc[ai][bj][m][n]; }
    }
};

struct EpiCmp {
    static constexpr bool PERM = true;
    bf16* H; const float* bias1;
    __device__ __forceinline__ void operator()(const f32x4 (&acc)[2][2][4][2], const Unit& u, int wr, int wc, int fr, int fq) const {
        const int row0 = u.pm * BM + wr * 64 + fr, col0 = wc * 32 + 8 * fq;
        const float* bz = bias1 + u.tag * 256;
#pragma unroll
        for (int bj = 0; bj < 2; ++bj) {
            const f32x4 b0 = *(const f32x4*)(bz + col0 + bj * HALF), b1 = *(const f32x4*)(bz + col0 + bj * HALF + 4);
#pragma unroll
            for (int ai = 0; ai < 2; ++ai)
#pragma unroll
                for (int m = 0; m < 4; ++m) {
                    const f32x4 v0 = acc[ai][bj][m][0] + b0, v1 = acc[ai][bj][m][1] + b1;
                    u32x4 w; w.x = cvtpk(gelu_tanh(v0[0]), gelu_tanh(v0[1])); w.y = cvtpk(gelu_tanh(v0[2]), gelu_tanh(v0[3]));
                    w.z = cvtpk(gelu_tanh(v1[0]), gelu_tanh(v1[1])); w.w = cvtpk(gelu_tanh(v1[2]), gelu_tanh(v1[3]));
                    *(u32x4*)(H + (size_t)(row0 + ai * HALF + m * 16) * 256 + col0 + bj * HALF) = w;
                }
        }
    }
};

struct EpiMemKV {
    static constexpr bool PERM = true;
    bf16* MK; bf16* MVT;
    __device__ __forceinline__ void operator()(const f32x4 (&acc)[2][2][4][2], const Unit& u, int wr, int wc, int fr, int fq) const {
        const int row0 = u.pm * BM + wr * 64 + fr;
#pragma unroll
        for (int bj = 0; bj < 2; ++bj) {
            const int col = u.pn * BM + bj * HALF + wc * 32 + 8 * fq;
            const int kvsel = col >> 9, head = (col >> 7) & 3, d0 = col & 127;
#pragma unroll
            for (int ai = 0; ai < 2; ++ai)
#pragma unroll
                for (int m = 0; m < 4; ++m) {
                    const int row = row0 + ai * HALF + m * 16, b = row >> 8, mm = row & 255;
                    const f32x4 v0 = acc[ai][bj][m][0], v1 = acc[ai][bj][m][1];
                    if (kvsel == 0) {
                        u32x4 w; w.x = cvtpk(v0[0], v0[1]); w.y = cvtpk(v0[2], v0[3]); w.z = cvtpk(v1[0], v1[1]); w.w = cvtpk(v1[2], v1[3]);
                        *(u32x4*)(MK + ((size_t)((b * 4 + head) * 256 + mm)) * 128 + d0) = w;
                    } else {
                        const int kk = mm & 31, pos = (kk & 16) | (kk & 3) | (((kk >> 3) & 1) << 2) | (((kk >> 2) & 1) << 3);
                        bf16* base = MVT + ((size_t)((b * 4 + head) * 8 + (mm >> 5)) * 128 + d0) * 32 + pos;
#pragma unroll
                        for (int e = 0; e < 4; ++e) { base[(size_t)e * 32] = f2bf(v0[e]); base[(size_t)(e + 4) * 32] = f2bf(v1[e]); }
                    }
                }
        }
    }
};

struct EpiIn {
    static constexpr bool PERM = true;
    bf16* upool; bf16* q; bf16* qx; bf16* gbr; float* gnsa; bf16* kv; const float* rope;
    __device__ __forceinline__ void operator()(const f32x4 (&acc_in)[2][2][4][2], const Unit& u, int wr, int wc, int fr, int fq) const {
        const int pn = u.pn, row0 = u.pm * BM + wr * 64 + fr, cl = wc * 32 + 8 * fq;
        const bool rotw = (pn >= 2 && pn < 9) && ((wc & 1) == 0);
#pragma unroll
        for (int ai = 0; ai < 2; ++ai)
#pragma unroll
            for (int m = 0; m < 4; ++m) {
                const int row = row0 + ai * HALF + m * 16;
#pragma unroll
                for (int bj = 0; bj < 2; ++bj) {
                    f32x4 v0 = acc_in[ai][bj][m][0], v1 = acc_in[ai][bj][m][1];
                    const bool rot_here = rotw && (pn < 6 || bj == 0);
                    if (rot_here) {
                        f32x4 y0, y1;
#pragma unroll
                        for (int e = 0; e < 4; ++e) { y0[e] = __shfl_xor(v0[e], 16); y1[e] = __shfl_xor(v1[e], 16); }
                        if (fq < 2) {
                            const f32x4 c0 = *(const f32x4*)(rope + (size_t)row * 16), c1 = *(const f32x4*)(rope + (size_t)row * 16 + 4);
                            const f32x4 s0 = *(const f32x4*)(rope + (size_t)row * 16 + 8), s1 = *(const f32x4*)(rope + (size_t)row * 16 + 12);
                            const float sg = fq == 0 ? -1.f : 1.f;
                            v0 = v0 * c0 + sg * (y0 * s0); v1 = v1 * c1 + sg * (y1 * s1);
                        }
                    }
                    if (pn < 2) {
                        u32x4 w; w.x = cvtpk(v0[0], v0[1]); w.y = cvtpk(v0[2], v0[3]); w.z = cvtpk(v1[0], v1[1]); w.w = cvtpk(v1[2], v1[3]);
                        *(u32x4*)(upool + (size_t)row * 512 + pn * 256 + bj * HALF + cl) = w;
                    } else if (pn < 6) {
                        v0 = v0 * QSCALE; v1 = v1 * QSCALE;
                        u32x4 w; w.x = cvtpk(v0[0], v0[1]); w.y = cvtpk(v0[2], v0[3]); w.z = cvtpk(v1[0], v1[1]); w.w = cvtpk(v1[2], v1[3]);
                        *(u32x4*)(q + (size_t)row * 1024 + (pn - 2) * 256 + bj * HALF + cl) = w;
                    } else if (pn < 9) {
                        const int j = 2 * (pn - 6) + bj, gg = wc >> 1, d0 = (wc & 1) * 32 + 8 * fq, b = row >> 13, t = row & 8191;
                        bf16* slab = kv + (size_t)j * KVSLAB;
                        if (j == 3) {
                            const int kk = t & 63, pos = (kk & 32) | (kk & 3) | (((kk >> 4) & 1) << 2) | (((kk >> 2) & 3) << 3);
                            bf16* base = slab + ((size_t)((b * 2 + gg) * 128 + (t >> 6)) * 64 + d0) * 64 + pos;
#pragma unroll
                            for (int e = 0; e < 4; ++e) { base[(size_t)e * 64] = f2bf(v0[e]); base[(size_t)(e + 4) * 64] = f2bf(v1[e]); }
                        } else if (j == 5) {
                            const int kk = t & 31, pos = (kk & 16) | (kk & 3) | (((kk >> 3) & 1) << 2) | (((kk >> 2) & 1) << 3);
                            bf16* base = slab + ((size_t)((b * 2 + gg) * 256 + (t >> 5)) * 64 + d0) * 32 + pos;
#pragma unroll
                            for (int e = 0; e < 4; ++e) { base[(size_t)e * 32] = f2bf(v0[e]); base[(size_t)(e + 4) * 32] = f2bf(v1[e]); }
                        } else {
                            u32x4 w; w.x = cvtpk(v0[0], v0[1]); w.y = cvtpk(v0[2], v0[3]); w.z = cvtpk(v1[0], v1[1]); w.w = cvtpk(v1[2], v1[3]);
                            *(u32x4*)(slab + ((size_t)((b * 2 + gg) * 8192 + t)) * 64 + d0) = w;
                        }
                    } else if (pn == 9) {
                        const int c0 = bj * HALF + cl;
#pragma unroll
                        for (int e = 0; e < 4; ++e) { if (c0 + e < 48) gnsa[(size_t)row * 48 + c0 + e] = sigmoidf_(v0[e]); if (c0 + 4 + e < 48) gnsa[(size_t)row * 48 + c0 + 4 + e] = sigmoidf_(v1[e]); }
                    } else if (pn < 12) {
                        v0 = v0 * QXSCALE; v1 = v1 * QXSCALE;
                        u32x4 w; w.x = cvtpk(v0[0], v0[1]); w.y = cvtpk(v0[2], v0[3]); w.z = cvtpk(v1[0], v1[1]); w.w = cvtpk(v1[2], v1[3]);
                        *(u32x4*)(qx + (size_t)row * 512 + (pn - 10) * 256 + bj * HALF + cl) = w;
                    } else {
                        u32x4 w; w.x = cvtpk(sigmoidf_(v0[0]), sigmoidf_(v0[1])); w.y = cvtpk(sigmoidf_(v0[2]), sigmoidf_(v0[3]));
                        w.z = cvtpk(sigmoidf_(v1[0]), sigmoidf_(v1[1])); w.w = cvtpk(sigmoidf_(v1[2]), sigmoidf_(v1[3]));
                        *(u32x4*)(gbr + (size_t)row * 3072 + (pn - 12) * 256 + bj * HALF + cl) = w;
                    }
                }
            }
    }
};

struct EpiGate {
    static constexpr bool PERM = true;
    const bf16* gbr; float* Y32; bf16* Y;
    __device__ __forceinline__ void operator()(const f32x4 (&acc)[2][2][4][2], const Unit& u, int wr, int wc, int fr, int fq) const {
        const int row0 = u.pm * BM + wr * 64 + fr, br = u.tag;
#pragma unroll
        for (int ai = 0; ai < 2; ++ai)
#pragma unroll
            for (int m = 0; m < 4; ++m) {
                const int row = row0 + ai * HALF + m * 16;
#pragma unroll
                for (int bj = 0; bj < 2; ++bj) {
                    const int col = u.pn * BM + bj * HALF + wc * 32 + 8 * fq;
                    const u32x4 gw = *(const u32x4*)(gbr + (size_t)row * 3072 + br * 1024 + col);
                    f32x4 v0 = acc[ai][bj][m][0], v1 = acc[ai][bj][m][1];
                    v0[0] *= bflo(gw.x); v0[1] *= bfhi(gw.x); v0[2] *= bflo(gw.y); v0[3] *= bfhi(gw.y);
                    v1[0] *= bflo(gw.z); v1[1] *= bfhi(gw.z); v1[2] *= bflo(gw.w); v1[3] *= bfhi(gw.w);
                    float* yp = Y32 + (size_t)row * 1024 + col;
                    if (br != 0) { v0 = v0 + *(const f32x4*)yp; v1 = v1 + *(const f32x4*)(yp + 4); }
                    if (br != 2) { *(f32x4*)yp = v0; *(f32x4*)(yp + 4) = v1; }
                    else { u32x4 w; w.x = cvtpk(v0[0], v0[1]); w.y = cvtpk(v0[2], v0[3]); w.z = cvtpk(v1[0], v1[1]); w.w = cvtpk(v1[2], v1[3]);
                           *(u32x4*)(Y + (size_t)row * 1024 + col) = w; }
                }
            }
    }
};

struct EpiConv {
    static constexpr bool PERM = true;
    bf16* A2; bf16* halo; const float* cw; const float* cb;
    __device__ __forceinline__ void operator()(const f32x4 (&acc)[2][2][4][2], const Unit& u, int wr, int wc, int fr, int fq) const {
        const int lane = threadIdx.x & 63;
        const int src1 = (lane & 48) | ((fr - 1) & 15), src2 = (lane & 48) | ((fr - 2) & 15);
        const int chb = u.pn * 128 + wc * 32 + 8 * fq;
        const int ncol0 = u.pn * 256 + wc * 32 + 8 * fq;
#pragma unroll
        for (int n = 0; n < 2; ++n) {
            const int ch = chb + 4 * n;
            f32x4 w0[2], w1[2], w2[2], bb[2];
#pragma unroll
            for (int bj = 0; bj < 2; ++bj) { const int ci = bj * DFF + ch;
                w0[bj] = *(const f32x4*)(cw + ci); w1[bj] = *(const f32x4*)(cw + DFF2 + ci); w2[bj] = *(const f32x4*)(cw + 2 * DFF2 + ci); bb[bj] = *(const f32x4*)(cb + ci); }
#pragma unroll
            for (int ai = 0; ai < 2; ++ai) {
                const int kk = 4 * u.pm + 2 * ai + wr;
#pragma unroll
                for (int m = 0; m < 4; ++m) {
                    const int row = kk * 64 + m * 16 + fr;
                    f32x4 cv[2];
#pragma unroll
                    for (int bj = 0; bj < 2; ++bj) {
                        const f32x4 cur = acc[ai][bj][m][n];
                        const f32x4 prv = m > 0 ? acc[ai][bj][m - 1][n] : (f32x4){0.f, 0.f, 0.f, 0.f};
                        f32x4 u1, u2;
#pragma unroll
                        for (int e = 0; e < 4; ++e) {
                            const float d1 = fr == 15 ? prv[e] : cur[e];
                            const float d2 = fr >= 14 ? prv[e] : cur[e];
                            u1[e] = __shfl(d1, src1); u2[e] = __shfl(d2, src2);
                        }
                        cv[bj] = bb[bj] + w0[bj] * u2 + w1[bj] * u1 + w2[bj] * cur;
                        if ((m == 3 && fr >= 14) || (m == 0 && fr < 2)) {
                            const int hk = m == 3 ? kk + 1 : kk, hr = m == 3 ? fr - 14 : 2 + fr;
                            u32x2 w; w.x = cvtpk(cur[0], cur[1]); w.y = cvtpk(cur[2], cur[3]);
                            *(u32x2*)(halo + ((size_t)(hk * 4 + hr)) * DFF2 + ncol0 + bj * HALF + 4 * n) = w;
                        }
                    }
                    if (!(m == 0 && fr < 2)) {
                        u32x2 w; w.x = cvtpk(gelu_tanh(cv[0][0]) * cv[1][0], gelu_tanh(cv[0][1]) * cv[1][1]);
                        w.y = cvtpk(gelu_tanh(cv[0][2]) * cv[1][2], gelu_tanh(cv[0][3]) * cv[1][3]);
                        *(u32x2*)(A2 + (size_t)row * DFF + ch) = w;
                    }
                }
            }
        }
    }
};
}

typedef GAS unsigned gu32;
#define RLX_AGENT __ATOMIC_RELAXED, __HIP_MEMORY_SCOPE_AGENT
#define XB_TMO      128
#define XB_XCNT(j)  (256  + 64 * (j))
#define XB_XSUB(j)  (1280 + 64 * (j))
#define XB_XGEN(j)  (2304 + 64 * (j))
#define XB_TOP      3328
#define XB_TOPGEN   3392
#define XCD_BAR_WORDS 3456
#define XB_SPIN_CAP (1u << 22)
__device__ __forceinline__ unsigned xb_ld(unsigned* p)              { return __hip_atomic_load(p, __ATOMIC_RELAXED, __HIP_MEMORY_SCOPE_AGENT); }
__device__ __forceinline__ unsigned xb_add(unsigned* p, unsigned v) { return __hip_atomic_fetch_add(p, v, __ATOMIC_RELAXED, __HIP_MEMORY_SCOPE_AGENT); }
__device__ __forceinline__ unsigned xb_xcc_id() { return (unsigned)__builtin_amdgcn_s_getreg((3 << 11) | 20) & 0xFu; }
#define XB_SPIN(cond, bar) do { unsigned _sp = 0; while (cond) { __builtin_amdgcn_s_sleep(1); \
    if ((++_sp & 255u) == 0u) { if (xb_ld(&(bar)[XB_TMO])) break; if (_sp > XB_SPIN_CAP) { atomicAdd(&(bar)[XB_TMO], 1u); break; } } } } while (0)
struct XcdBarrier { unsigned* bar; unsigned x; volatile LAS unsigned* st; };
__device__ __forceinline__ XcdBarrier xcd_barrier_post(unsigned* bar, volatile LAS unsigned* st) {
    XcdBarrier b; b.bar = bar; b.x = xb_xcc_id(); b.st = st;
    if (threadIdx.x == 0) (void)xb_add(&bar[XB_XCNT(b.x)], 1u);
    return b;
}
__device__ __forceinline__ void xcd_barrier_complete(unsigned* bar, unsigned x, unsigned& nloc, unsigned& nx) {
    const unsigned G = gridDim.x * gridDim.y * gridDim.z;
    unsigned sum, cnt, mine, sp = 0u;
    for (;;) {
        sum = 0u; cnt = 0u; mine = 0u;
#pragma unroll
        for (unsigned j = 0; j < 16; ++j) { const unsigned c = xb_ld(&bar[XB_XCNT(j)]); sum += c; cnt += (c > 0u) ? 1u : 0u; mine = (j == x) ? c : mine; }
        if (sum == G) break;
        __builtin_amdgcn_s_sleep(1);
        if ((++sp & 255u) == 0u) { if (xb_ld(&bar[XB_TMO])) break; if (sp > XB_SPIN_CAP) { atomicAdd(&bar[XB_TMO], 1u); break; } }
    }
    nloc = mine > 0u ? mine : 1u; nx = cnt > 0u ? cnt : 1u;
}
__device__ __forceinline__ void xcd_barrier(const XcdBarrier& b) {
    asm volatile("s_waitcnt vmcnt(0)" ::: "memory");
    __syncthreads();
    if (threadIdx.x == 0) {
        unsigned* bar = b.bar;
        __builtin_amdgcn_s_waitcnt(0);
        unsigned nloc = b.st[0], nx = b.st[1];
        if (nloc == 0u) { xcd_barrier_complete(bar, b.x, nloc, nx); b.st[0] = nloc; b.st[1] = nx; }
        const unsigned old = xb_add(&bar[XB_XSUB(b.x)], 1u);
        const unsigned gen = old / nloc;
        if (old + 1u == (gen + 1u) * nloc) {
            __builtin_amdgcn_fence(__ATOMIC_RELEASE, "agent");
            asm volatile("s_waitcnt vmcnt(0)" ::: "memory");
            const unsigned og = xb_add(&bar[XB_TOP], 1u);
            const unsigned tg = og / nx;
            if (og + 1u == (tg + 1u) * nx) xb_add(&bar[XB_TOPGEN], 1u);
            else XB_SPIN(xb_ld(&bar[XB_TOPGEN]) == tg, bar);
            __builtin_amdgcn_fence(__ATOMIC_ACQUIRE, "agent");
            xb_add(&bar[XB_XGEN(b.x)], 1u);
            asm volatile("s_waitcnt vmcnt(0)" ::: "memory");
        } else {
            XB_SPIN(xb_ld(&bar[XB_XGEN(b.x)]) == gen, bar);
            __builtin_amdgcn_fence(__ATOMIC_ACQUIRE, "agent");
            asm volatile("s_waitcnt vmcnt(0)" ::: "memory");
        }
    }
    __syncthreads();
}

struct Args {
    const float* in[23]; float* out; unsigned char* ws;
    float invf[8];
    int ph_lo, ph_hi;
};

struct Frame {
    LAS unsigned char* lds;
    int tid, lane, wave, vcu, G, bx;
};

template <class Map>
__device__ __forceinline__ void transpose_item(const float* W, int N, bf16* WT, int ldt, int koff, LAS float* scr, int nblk, int item, int lane, Map map) {
    const int kb = item / nblk, nb = item % nblk, k0 = 64 * kb, n0 = 32 * nb;
    const int sc = map(n0 + (lane & 31));
#pragma unroll 8
    for (int i = 0; i < 32; ++i) { const int kk = 2 * i + (lane >> 5); scr[kk * 33 + (lane & 31)] = sc >= 0 ? W[(size_t)(k0 + kk) * N + sc] : 0.f; }
    LDS_WAIT(); asm volatile("" ::: "memory");
    const int c = lane & 7;
#pragma unroll
    for (int j = 0; j < 4; ++j) { const int n = (lane >> 3) + 8 * j; const LAS float* s = scr + (8 * c) * 33 + n;
        u32x4 o; o.x = cvtpk(s[0 * 33], s[1 * 33]); o.y = cvtpk(s[2 * 33], s[3 * 33]); o.z = cvtpk(s[4 * 33], s[5 * 33]); o.w = cvtpk(s[6 * 33], s[7 * 33]);
        *(u32x4*)(WT + (size_t)(n0 + n) * ldt + koff + k0 + 8 * c) = o; }
    LDS_WAIT(); asm volatile("" ::: "memory");
}
struct MapId { __device__ __forceinline__ int operator()(int n) const { return n; } };
struct MapIn { __device__ __forceinline__ int operator()(int n) const { return n < 2352 ? n : (n < 2560 ? -1 : n - 208); } };
struct MapUp { __device__ __forceinline__ int operator()(int n) const { const int pn = n >> 8, r = n & 255; return r < 128 ? pn * 128 + r : DFF + pn * 128 + r - 128; } };

__device__ __forceinline__ void rms_row_to_bf16(const float* xrow, const float* g, bf16* orow, int lane) {
    const f32x4* xr = (const f32x4*)xrow + lane; const f32x4* gr = (const f32x4*)g + lane;
    f32x4 v[4]; float s = 0.f;
#pragma unroll
    for (int j = 0; j < 4; ++j) { v[j] = xr[64 * j]; s += (v[j].x * v[j].x + v[j].y * v[j].y) + (v[j].z * v[j].z + v[j].w * v[j].w); }
    const float rstd = 1.0f / sqrtf(wave_sum(s) * (1.f / DM) + EPS);
    u32x2* o8 = (u32x2*)orow + lane;
#pragma unroll
    for (int j = 0; j < 4; ++j) { const f32x4 gg = gr[64 * j]; u32x2 w; w.x = cvtpk(v[j].x * rstd * gg.x, v[j].y * rstd * gg.y); w.y = cvtpk(v[j].z * rstd * gg.z, v[j].w * rstd * gg.w); o8[64 * j] = w; }
}

__device__ __forceinline__ int krow(int reg, int h) { return (reg & 3) + 8 * (reg >> 2) + 4 * h; }

struct MaskCmp { int tq[2]; __device__ __forceinline__ bool operator()(int T, int kr, int qb) const { return 16 * (32 * T + kr) + 31 <= tq[qb]; } };
struct MaskWin { int tq[2]; int base; __device__ __forceinline__ bool operator()(int T, int kr, int qb) const { const int kp = base + 32 * T + kr; return kp <= tq[qb] && tq[qb] - kp < 512; } };
struct MaskNone { __device__ __forceinline__ bool operator()(int, int, int) const { return true; } };

template <int HD, int NQB, bool IMP, class Mask>
__device__ __forceinline__ void attn2pass(LAS unsigned char* lds, const bf16* Kg, const bf16* Vg, int T0, int T1, const bf16x8 (&Qf)[NQB][HD / 16],
                                          const Mask& mask, const float (&gate)[NQB], f32x16 (&O)[HD / 32][NQB], LAS unsigned* imp, int tid, int lane) {
    constexpr int KSTR = HD * 2 + 16, VSTR = 80, KBYTES = 32 * KSTR, VBYTES = HD * VSTR;
    constexpr int KCH = 32 * HD * 2 / 16, VCH = KCH;
    constexpr int CPR = HD * 2 / 16;
    LAS unsigned char* KB = lds; LAS unsigned char* VB = lds + 2 * KBYTES;
    const int r32 = lane & 31, h = lane >> 5;
    float mrun[NQB], lrun[NQB];
#pragma unroll
    for (int qb = 0; qb < NQB; ++qb) { mrun[qb] = -1e29f; lrun[qb] = 0.f; }
    u32x4 kreg = (u32x4){0u, 0u, 0u, 0u}, vreg = (u32x4){0u, 0u, 0u, 0u};
    if (T0 < T1 && tid < KCH) kreg = *(const u32x4*)(Kg + (size_t)T0 * 32 * HD + tid * 8);
    for (int T = T0; T < T1; ++T) {
        if (tid < KCH) *(LAS u32x4*)(KB + (T & 1) * KBYTES + (tid / CPR) * KSTR + (tid % CPR) * 16) = kreg;
        __syncthreads();
        if (T + 1 < T1 && tid < KCH) kreg = *(const u32x4*)(Kg + (size_t)(T + 1) * 32 * HD + tid * 8);
        const LAS unsigned char* kb = KB + (T & 1) * KBYTES + r32 * KSTR + h * 16;
        f32x16 S[NQB];
#pragma unroll
        for (int qb = 0; qb < NQB; ++qb) S[qb] = (f32x16){0.f,0.f,0.f,0.f,0.f,0.f,0.f,0.f,0.f,0.f,0.f,0.f,0.f,0.f,0.f,0.f};
#pragma unroll
        for (int s = 0; s < HD / 16; ++s) { const bf16x8 kf = *(const LAS bf16x8*)(kb + s * 32);
#pragma unroll
            for (int qb = 0; qb < NQB; ++qb) S[qb] = __builtin_amdgcn_mfma_f32_32x32x16_bf16(kf, Qf[qb][s], S[qb], 0, 0, 0); }
#pragma unroll
        for (int qb = 0; qb < NQB; ++qb) {
            float tm = -1e30f;
#pragma unroll
            for (int r = 0; r < 16; ++r) { S[qb][r] = mask(T, krow(r, h), qb) ? S[qb][r] : -1e30f; tm = fmaxf(tm, S[qb][r]); }
            const float mn = fmaxf(mrun[qb], tm);
            float sum = 0.f;
#pragma unroll
            for (int r = 0; r < 16; ++r) sum += __builtin_amdgcn_exp2f(S[qb][r] - mn);
            lrun[qb] = lrun[qb] * __builtin_amdgcn_exp2f(mrun[qb] - mn) + sum; mrun[qb] = mn;
        }
    }
    float inv[NQB];
#pragma unroll
    for (int qb = 0; qb < NQB; ++qb) {
        const float mo = __shfl_xor(mrun[qb], 32), lo = __shfl_xor(lrun[qb], 32);
        const float M = fmaxf(mrun[qb], mo);
        const float L = lrun[qb] * __builtin_amdgcn_exp2f(mrun[qb] - M) + lo * __builtin_amdgcn_exp2f(mo - M);
        mrun[qb] = M; inv[qb] = L > 0.f ? 1.0f / L : 0.f;
    }
    __syncthreads();
    if (T0 < T1) { if (tid < KCH) kreg = *(const u32x4*)(Kg + (size_t)T0 * 32 * HD + tid * 8);
                   if (tid >= 512 - VCH) vreg = *(const u32x4*)(Vg + (size_t)T0 * HD * 32 + (tid - (512 - VCH)) * 8); }
    for (int T = T0; T < T1; ++T) {
        if (tid < KCH) *(LAS u32x4*)(KB + (T & 1) * KBYTES + (tid / CPR) * KSTR + (tid % CPR) * 16) = kreg;
        if (tid >= 512 - VCH) { const int vi = tid - (512 - VCH); *(LAS u32x4*)(VB + (T & 1) * VBYTES + (vi >> 2) * VSTR + (vi & 3) * 16) = vreg; }
        __syncthreads();
        if (T + 1 < T1) { if (tid < KCH) kreg = *(const u32x4*)(Kg + (size_t)(T + 1) * 32 * HD + tid * 8);
                          if (tid >= 512 - VCH) vreg = *(const u32x4*)(Vg + (size_t)(T + 1) * HD * 32 + (tid - (512 - VCH)) * 8); }
        const LAS unsigned char* kb = KB + (T & 1) * KBYTES + r32 * KSTR + h * 16;
        const LAS unsigned char* vb = VB + (T & 1) * VBYTES + r32 * VSTR + h * 16;
        f32x16 S[NQB];
#pragma unroll
        for (int qb = 0; qb < NQB; ++qb) S[qb] = (f32x16){0.f,0.f,0.f,0.f,0.f,0.f,0.f,0.f,0.f,0.f,0.f,0.f,0.f,0.f,0.f,0.f};
#pragma unroll
        for (int s = 0; s < HD / 16; ++s) { const bf16x8 kf = *(const LAS bf16x8*)(kb + s * 32);
#pragma unroll
            for (int qb = 0; qb < NQB; ++qb) S[qb] = __builtin_amdgcn_mfma_f32_32x32x16_bf16(kf, Qf[qb][s], S[qb], 0, 0, 0); }
        bf16x8 Pf[NQB][2];
#pragma unroll
        for (int qb = 0; qb < NQB; ++qb) {
            f32x16& p = S[qb];
#pragma unroll
            for (int r = 0; r < 16; ++r) { const float sv = mask(T, krow(r, h), qb) ? S[qb][r] : -1e30f; p[r] = __builtin_amdgcn_exp2f(sv - mrun[qb]) * inv[qb]; }
            if constexpr (IMP) {
                const int qrow = (32 * qb + r32) * IMP_STRIDE;
#pragma unroll
                for (int a = 0; a < 4; ++a) {
                    const int jp = 8 * T + 2 * a + h;
                    const float g4 = (p[4 * a] + p[4 * a + 1]) + (p[4 * a + 2] + p[4 * a + 3]), e3 = p[4 * a + 3];
                    if (g4 > 0.f) {
                        atomicAdd((unsigned*)(imp + qrow + jp), (unsigned)(g4 * 16777216.f + 0.5f));
                        if (jp + 1 < 128) atomicAdd((unsigned*)(imp + qrow + jp + 1), (unsigned)(e3 * 16777216.f + 0.5f));
                    }
                }
            }
            const float gt = gate[qb];
#pragma unroll
            for (int s2 = 0; s2 < 2; ++s2) { u32x4 w; w.x = cvtpk(p[8 * s2] * gt, p[8 * s2 + 1] * gt); w.y = cvtpk(p[8 * s2 + 2] * gt, p[8 * s2 + 3] * gt);
                w.z = cvtpk(p[8 * s2 + 4] * gt, p[8 * s2 + 5] * gt); w.w = cvtpk(p[8 * s2 + 6] * gt, p[8 * s2 + 7] * gt); Pf[qb][s2] = __builtin_bit_cast(bf16x8, w); }
        }
#pragma unroll
        for (int db = 0; db < HD / 32; ++db)
#pragma unroll
            for (int s2 = 0; s2 < 2; ++s2) { const bf16x8 vf = *(const LAS bf16x8*)(vb + db * 32 * VSTR + s2 * 32);
#pragma unroll
                for (int qb = 0; qb < NQB; ++qb) O[db][qb] = __builtin_amdgcn_mfma_f32_32x32x16_bf16(vf, Pf[qb][s2], O[db][qb], 0, 0, 0); }
    }
    __syncthreads();
}

__device__ __forceinline__ void nsa_unit(Frame& F, int b, int g, int c, const bf16* q, const float* gnsa, const bf16* kc, const bf16* vct,
                                         const bf16* kvs, bf16* acat) {
    LAS unsigned char* lds = F.lds;
    int tid = F.tid; asm volatile("" : "+v"(tid));
    const int lane = tid & 63, w = F.wave, r32 = lane & 31, h = lane >> 5;
    LAS unsigned* imp = (LAS unsigned*)(lds + L_IMP);
    LAS int* sel = (LAS int*)(lds + L_SEL);
    LAS int* selcnt = (LAS int*)(lds + L_SELCNT);
    LAS unsigned char* yt = lds + L_YT;
    const int bg = b * 2 + g, head = 8 * g + w;
    const size_t rowbase = (size_t)b * SEQ + 64 * c;
    for (int i = tid; i < 64 * IMP_STRIDE; i += 512) imp[i] = 0u;
    bf16x8 Qf[2][4]; float g0[2], g2[2]; int tq[2];
#pragma unroll
    for (int qb = 0; qb < 2; ++qb) {
        const size_t row = rowbase + 32 * qb + r32; tq[qb] = 64 * c + 32 * qb + r32;
#pragma unroll
        for (int s = 0; s < 4; ++s) Qf[qb][s] = *(const bf16x8*)(q + row * 1024 + head * 64 + 16 * s + 8 * h);
        g0[qb] = gnsa[row * 48 + head * 3 + 0]; g2[qb] = gnsa[row * 48 + head * 3 + 2];
    }
    f32x16 O[2][2];
#pragma unroll
    for (int db = 0; db < 2; ++db)
#pragma unroll
        for (int qb = 0; qb < 2; ++qb) O[db][qb] = (f32x16){0.f,0.f,0.f,0.f,0.f,0.f,0.f,0.f,0.f,0.f,0.f,0.f,0.f,0.f,0.f,0.f};
    __syncthreads();
#ifndef NO_CMP
    { MaskCmp mk; mk.tq[0] = tq[0]; mk.tq[1] = tq[1];
      const int NT = (4 * c + 2) / 32 + 1;
      attn2pass<64, 2, true>(lds, kc + (size_t)bg * 512 * 64, vct + (size_t)bg * 16 * 2048, 0, NT, Qf, mk, g0, O, imp, tid, lane); }
#endif
#ifndef NO_TOPK
    for (int qi = 0; qi < 8; ++qi) {
        const int ql = 8 * w + qi;
        if (c < 16) {
            if (lane <= c) sel[ql * 16 + lane] = lane;
            if (lane == 0) selcnt[ql] = c + 1;
        } else {
            const int hi = c - 2;
            const int j0 = 1 + lane, j1 = 65 + lane;
            const unsigned v0 = j0 <= hi ? imp[ql * IMP_STRIDE + j0] : 0u, v1 = j1 <= hi ? imp[ql * IMP_STRIDE + j1] : 0u;
            int r0 = 0, r1 = 0;
            for (int jj = 1; jj <= hi; ++jj) { const unsigned vv = imp[ql * IMP_STRIDE + jj];
                r0 += (vv > v0 || (vv == v0 && jj < j0)) ? 1 : 0; r1 += (vv > v1 || (vv == v1 && jj < j1)) ? 1 : 0; }
            const bool s0 = j0 <= hi && r0 < 13, s1 = j1 <= hi && r1 < 13;
            const unsigned long long m0 = __ballot(s0), m1 = __ballot(s1), lt = (1ull << lane) - 1ull;
            if (s0) sel[ql * 16 + 3 + __popcll(m0 & lt)] = j0;
            if (s1) sel[ql * 16 + 3 + __popcll(m0) + __popcll(m1 & lt)] = j1;
            if (lane == 0) { sel[ql * 16 + 0] = 0; sel[ql * 16 + 1] = c - 1; sel[ql * 16 + 2] = c; selcnt[ql] = 16; }
        }
    }
#endif
#ifndef NO_WIN
    { MaskWin mk; mk.tq[0] = tq[0]; mk.tq[1] = tq[1]; mk.base = 64 * c - 512;
      const int T0 = (16 - 2 * c) > 0 ? (16 - 2 * c) : 0;
      const bf16* kw = kvs + 4 * KVSLAB + ((size_t)bg * 8192 + 64 * c - 512) * 64;
      const bf16* vw = kvs + 5 * KVSLAB + ((size_t)bg * 256 + 2 * c - 16) * 2048;
      attn2pass<64, 2, false>(lds, kw, vw, T0, 18, Qf, mk, g2, O, imp, tid, lane); }
#endif
#pragma unroll
    for (int db = 0; db < 2; ++db)
#pragma unroll
        for (int qb = 0; qb < 2; ++qb)
#pragma unroll
            for (int a = 0; a < 4; ++a) {
                u32x2 wv; wv.x = cvtpk(O[db][qb][4 * a], O[db][qb][4 * a + 1]); wv.y = cvtpk(O[db][qb][4 * a + 2], O[db][qb][4 * a + 3]);
                *(LAS u32x2*)(yt + (32 * qb + r32) * YT_STRIDE + (w * 64 + 32 * db + 8 * a + 4 * h) * 2) = wv;
            }
    __syncthreads();
#ifndef NO_SEL
    {
        int lane_o = lane; asm volatile("" : "+v"(lane_o));
        const int n16 = lane_o & 15, kq = lane_o >> 4;
        const bf16* ksb = kvs + 2 * KVSLAB + (size_t)bg * 8192 * 64;
        const bf16* vsb = kvs + 3 * KVSLAB + (size_t)bg * 128 * 4096;
        for (int qi = 0; qi < 8; ++qi) {
            const int ql = 8 * w + qi, t = 64 * c + ql; const size_t row = (size_t)b * SEQ + t;
            const int nsel = __builtin_amdgcn_readfirstlane(selcnt[ql]);
            bf16x8 Qb[2];
#pragma unroll
            for (int s = 0; s < 2; ++s) { u32x4 z = (u32x4){0u, 0u, 0u, 0u};
                if (n16 < 8) z = *(const u32x4*)(q + row * 1024 + (8 * g + n16) * 64 + 32 * s + 8 * kq);
                Qb[s] = __builtin_bit_cast(bf16x8, z); }
            float mrun = -1e29f, lrun = 0.f;
            f32x4 Os[4];
#pragma unroll
            for (int dt = 0; dt < 4; ++dt) Os[dt] = (f32x4){0.f, 0.f, 0.f, 0.f};
            for (int bi = 0; bi < nsel; ++bi) {
                const int jb = __builtin_amdgcn_readfirstlane(sel[ql * 16 + bi]);
                const bf16* Kblk = ksb + (size_t)jb * 4096; const bf16* Vblk = vsb + (size_t)jb * 4096;
                bf16x8 kA[4][2], vA[4][2];
#pragma unroll
                for (int kt = 0; kt < 4; ++kt)
#pragma unroll
                    for (int s = 0; s < 2; ++s) kA[kt][s] = *(const bf16x8*)(Kblk + (16 * kt + n16) * 64 + 32 * s + 8 * kq);
#pragma unroll
                for (int dt = 0; dt < 4; ++dt)
#pragma unroll
                    for (int s = 0; s < 2; ++s) vA[dt][s] = *(const bf16x8*)(Vblk + (16 * dt + n16) * 64 + 32 * s + 8 * kq);
                f32x4 S[4];
#pragma unroll
                for (int kt = 0; kt < 4; ++kt) { S[kt] = __builtin_amdgcn_mfma_f32_16x16x32_bf16(kA[kt][0], Qb[0], (f32x4){0.f, 0.f, 0.f, 0.f}, 0, 0, 0);
                    S[kt] = __builtin_amdgcn_mfma_f32_16x16x32_bf16(kA[kt][1], Qb[1], S[kt], 0, 0, 0); }
                const int kp0 = 64 * jb + 4 * kq;
                float bm = -1e30f;
#pragma unroll
                for (int kt = 0; kt < 4; ++kt)
#pragma unroll
                    for (int r = 0; r < 4; ++r) { S[kt][r] = (kp0 + 16 * kt + r <= t) ? S[kt][r] : -1e30f; bm = fmaxf(bm, S[kt][r]); }
                bm = fmaxf(bm, __shfl_xor(bm, 16)); bm = fmaxf(bm, __shfl_xor(bm, 32));
                const float mn = fmaxf(mrun, bm), alpha = __builtin_amdgcn_exp2f(mrun - mn);
                float sum = 0.f;
#pragma unroll
                for (int kt = 0; kt < 4; ++kt)
#pragma unroll
                    for (int r = 0; r < 4; ++r) { const float p = __builtin_amdgcn_exp2f(S[kt][r] - mn); S[kt][r] = p; sum += p; }
                lrun = lrun * alpha + sum; mrun = mn;
                bf16x8 Pb[2];
#pragma unroll
                for (int s = 0; s < 2; ++s) { u32x4 wv; wv.x = cvtpk(S[2 * s][0], S[2 * s][1]); wv.y = cvtpk(S[2 * s][2], S[2 * s][3]);
                    wv.z = cvtpk(S[2 * s + 1][0], S[2 * s + 1][1]); wv.w = cvtpk(S[2 * s + 1][2], S[2 * s + 1][3]); Pb[s] = __builtin_bit_cast(bf16x8, wv); }
#pragma unroll
                for (int dt = 0; dt < 4; ++dt) { Os[dt] = Os[dt] * alpha;
                    Os[dt] = __builtin_amdgcn_mfma_f32_16x16x32_bf16(vA[dt][0], Pb[0], Os[dt], 0, 0, 0);
                    Os[dt] = __builtin_amdgcn_mfma_f32_16x16x32_bf16(vA[dt][1], Pb[1], Os[dt], 0, 0, 0); }
            }
            float L = lrun; L += __shfl_xor(L, 16); L += __shfl_xor(L, 32);
            if (n16 < 8) {
                const float sc = (L > 0.f ? 1.0f / L : 0.f) * gnsa[row * 48 + (8 * g + n16) * 3 + 1];
#pragma unroll
                for (int dt = 0; dt < 4; ++dt) {
                    LAS u32x2* yp = (LAS u32x2*)(yt + ql * YT_STRIDE + (n16 * 64 + 16 * dt + 4 * kq) * 2);
                    const u32x2 old = *yp; u32x2 nw;
                    nw.x = cvtpk(bflo(old.x) + Os[dt][0] * sc, bfhi(old.x) + Os[dt][1] * sc);
                    nw.y = cvtpk(bflo(old.y) + Os[dt][2] * sc, bfhi(old.y) + Os[dt][3] * sc);
                    *yp = nw;
                }
            }
        }
    }
#endif
    __syncthreads();
#pragma unroll
    for (int i = 0; i < 8; ++i) { const int idx = tid + 512 * i, rr = idx >> 6, ch = idx & 63;
        const u32x4 v = *(const LAS u32x4*)(yt + rr * YT_STRIDE + ch * 16);
        *(u32x4*)(acat + (rowbase + rr) * 2048 + 512 + g * 512 + ch * 8) = v; }
    __syncthreads();
}

__device__ __forceinline__ void mem_unit(Frame& F, int b, int head, int chunk, const bf16* qx, const bf16* mk, const bf16* mvt, bf16* acat) {
    int lane = F.lane; asm volatile("" : "+v"(lane));
    const int r32 = lane & 31, h = lane >> 5;
    const size_t row = (size_t)b * SEQ + 256 * chunk + 32 * F.wave + r32;
    bf16x8 Qf[1][8];
#pragma unroll
    for (int s = 0; s < 8; ++s) Qf[0][s] = *(const bf16x8*)(qx + row * 512 + head * 128 + 16 * s + 8 * h);
    f32x16 O[4][1];
#pragma unroll
    for (int db = 0; db < 4; ++db) O[db][0] = (f32x16){0.f,0.f,0.f,0.f,0.f,0.f,0.f,0.f,0.f,0.f,0.f,0.f,0.f,0.f,0.f,0.f};
    const float gate[1] = {1.0f}; MaskNone mk0;
    attn2pass<128, 1, false>(F.lds, mk + (size_t)(b * 4 + head) * 256 * 128, mvt + (size_t)(b * 4 + head) * 8 * 4096, 0, 8, Qf, mk0, gate, O, (LAS unsigned*)nullptr, F.tid, lane);
#pragma unroll
    for (int db = 0; db < 4; ++db)
#pragma unroll
        for (int a = 0; a < 4; ++a) {
            u32x2 wv; wv.x = cvtpk(O[db][0][4 * a], O[db][0][4 * a + 1]); wv.y = cvtpk(O[db][0][4 * a + 2], O[db][0][4 * a + 3]);
            *(u32x2*)(acat + row * 2048 + 1536 + head * 128 + 32 * db + 8 * a + 4 * h) = wv;
        }
}

constexpr int NPHASE = 11;
__global__ void __launch_bounds__(512, 2) mk_fwd(Args args) {
    extern __shared__ __attribute__((aligned(16))) unsigned char lds_raw[];
    Frame F;
    F.lds = (LAS unsigned char*)lds_raw;
    F.tid = threadIdx.x; F.lane = F.tid & 63; F.wave = __builtin_amdgcn_readfirstlane(F.tid >> 6);
    F.G = gridDim.x; F.bx = blockIdx.x; F.vcu = (F.G % 8 == 0) ? (F.bx % 8) * (F.G / 8) + F.bx / 8 : F.bx;
    unsigned char* ws = args.ws;
    gu32* ctl = (gu32*)(ws + WS_CTL);
    volatile LAS unsigned* MISC = (volatile LAS unsigned*)(F.lds + MISC_OFF);
    for (int u = F.tid; u < (LDS_BYTES - LDSCTL_OFF) / 4; u += 512) ((LAS unsigned*)(F.lds + LDSCTL_OFF))[u] = 0u;
    __syncthreads();
#if MK_LAUNCHES == 1
    XcdBarrier bar = xcd_barrier_post((unsigned*)(ctl + CW_BAR), MISC + 8);
#define GRID_BAR() xcd_barrier(bar)
#else
#define GRID_BAR() do {} while (0)
#endif
    const int lo = args.ph_lo, hi = args.ph_hi;
#ifndef PH_MASK
#define PH_MASK 0x7ff
#endif
#define IN(k) ((((PH_MASK) >> (k)) & 1) && lo <= (k) && (k) < hi)
#define SEAM(k) do { if (IN(k) && IN((k) + 1)) GRID_BAR(); } while (0)
    const float* x = args.in[0]; const float* mem = args.in[1]; const int* positions = (const int*)args.in[2];
    const float* pre_mix_g = args.in[3]; const float* w_in = args.in[4]; const float* pool_w = args.in[5]; const float* pool_scale = args.in[6];
    const float* cmp_pe = args.in[7]; const float* cmp_w1 = args.in[8]; const float* cmp_w2 = args.in[9]; const float* mem_norm_g = args.in[10];
    const float* w_mem_kv = args.in[11]; const float* w_br_pool = args.in[12]; const float* w_br_nsa = args.in[13]; const float* w_br_xa = args.in[14];
    const float* w_out = args.in[15]; const float* post_mix_g = args.in[16]; const float* pre_ffn_g = args.in[17]; const float* w_up = args.in[18];
    const float* conv_w = args.in[19]; const float* conv_b = args.in[20]; const float* w_down = args.in[21]; const float* post_ffn_g = args.in[22];
    float* out = args.out;
    bf16* q_buf = (bf16*)out; bf16* qx_buf = (bf16*)((char*)out + 32 * MiB); bf16* upool = (bf16*)((char*)out + 48 * MiB);
    float* rope = (float*)(ws + WS_ROPE); float* bias1 = (float*)(ws + WS_BIAS1); float* b1part = (float*)(ws + WS_B1PART);
    bf16* wc2t = (bf16*)(ws + WS_WC2T); bf16* kc = (bf16*)(ws + WS_KC); bf16* vct = (bf16*)(ws + WS_VCT);
    bf16* memn = (bf16*)(ws + WS_MEMN); bf16* memk = (bf16*)(ws + WS_MEMK); bf16* memvt = (bf16*)(ws + WS_MEMVT);
    bf16* hid = (bf16*)(ws + WS_HID); float* gnsa = (float*)(ws + WS_GNSA);
    bf16* wcat = (bf16*)(ws + WS_WCAT); bf16* wout_t = (bf16*)(ws + WS_WOUT); bf16* wup_t = (bf16*)(ws + WS_WUP); bf16* wdown_t = (bf16*)(ws + WS_WDOWN);
    bf16* wmem_t = (bf16*)(ws + WS_WMEM); bf16* wc1_t = (bf16*)(ws + WS_WC1); bf16* win_t = (bf16*)(ws + WS_WIN);
    bf16* kvs = (bf16*)(ws + WS_KV); bf16* ybuf = (bf16*)(ws + WS_Y); float* fbuf = (float*)(ws + WS_F);
    bf16* acat = (bf16*)(ws + WS_ACAT); bf16* hbuf = (bf16*)(ws + WS_ACAT); bf16* gbr = (bf16*)(ws + WS_GBR); bf16* a2 = (bf16*)(ws + WS_A2); bf16* halo = (bf16*)(ws + WS_HALO);
    const int gw = F.vcu * 8 + F.wave, NGW = F.G * 8;
    const int gt = F.vcu * 512 + F.tid, NGT = F.G * 512;

    if (IN(0)) {
        LAS float* scr = (LAS float*)(F.lds + F.wave * 16384);
        constexpr int I_IN = 16 * 192, I_UP = 16 * 176, I_DN = 44 * 32, I_NSA = 16 * 32, I_XA = 8 * 32, I_OUT = 16 * 32, I_MEM = 16 * 32, I_C1 = 32 * 8, I_C2 = 4 * 2;
        constexpr int NITEMS = I_IN + I_UP + I_DN + I_NSA + I_XA + I_OUT + I_MEM + 2 * I_C1 + 2 * I_C2;
        for (int it = gw; it < NITEMS; it += NGW) {
            int r = it;
            if (r < I_IN) { transpose_item(w_in, DIN, win_t, 1024, 0, scr, 192, r, F.lane, MapIn()); continue; } r -= I_IN;
            if (r < I_UP) { transpose_item(w_up, DFF2, wup_t, 1024, 0, scr, 176, r, F.lane, MapUp()); continue; } r -= I_UP;
            if (r < I_DN) { transpose_item(w_down, 1024, wdown_t, DFF, 0, scr, 32, r, F.lane, MapId()); continue; } r -= I_DN;
            if (r < I_NSA) { transpose_item(w_br_nsa, 1024, wcat, 2048, 512, scr, 32, r, F.lane, MapId()); continue; } r -= I_NSA;
            if (r < I_XA) { transpose_item(w_br_xa, 1024, wcat, 2048, 1536, scr, 32, r, F.lane, MapId()); continue; } r -= I_XA;
            if (r < I_OUT) { transpose_item(w_out, 1024, wout_t, 1024, 0, scr, 32, r, F.lane, MapId()); continue; } r -= I_OUT;
            if (r < I_MEM) { transpose_item(w_mem_kv, 1024, wmem_t, 1024, 0, scr, 32, r, F.lane, MapId()); continue; } r -= I_MEM;
            if (r < 2 * I_C1) { const int z = r / I_C1; transpose_item(cmp_w1 + (size_t)z * 2048 * 256, 256, wc1_t + (size_t)z * 256 * 2048, 2048, 0, scr, 8, r % I_C1, F.lane, MapId()); continue; } r -= 2 * I_C1;
            { const int z = r / I_C2; transpose_item(cmp_w2 + (size_t)z * 256 * 64, 64, wc2t + (size_t)z * 64 * 256, 256, 0, scr, 2, r % I_C2, F.lane, MapId()); }
        }
        for (int m = gw; m < MTOK + 512; m += NGW) {
            if (m < MTOK) rms_row_to_bf16(x + (size_t)m * DM, pre_mix_g, hbuf + (size_t)m * DM, F.lane);
            else rms_row_to_bf16(mem + (size_t)(m - MTOK) * DM, mem_norm_g, memn + (size_t)(m - MTOK) * DM, F.lane);
        }
        for (int i = gt; i < MTOK * 8; i += NGT) { const int row = i >> 3, k = i & 7; const float ang = (float)positions[row] * args.invf[k];
            rope[(size_t)row * 16 + k] = cosf(ang); rope[(size_t)row * 16 + 8 + k] = sinf(ang); }
        for (int tsk = gw; tsk < 2 * 16 * 4; tsk += NGW) { const int z = tsk >> 6, kcn = (tsk >> 2) & 15, nb = tsk & 3, n = nb * 64 + F.lane;
            const float* pe = cmp_pe + (size_t)z * 2048 + kcn * 128; const float* w1 = cmp_w1 + ((size_t)z * 2048 + kcn * 128) * 256 + n; float s = 0.f;
#pragma unroll 8
            for (int k = 0; k < 128; ++k) s += pe[k] * w1[(size_t)k * 256];
            b1part[(z * 16 + kcn) * 256 + n] = s; }
        for (int tsk = gw; tsk < 64 * 16; tsk += NGW) { const int k8 = tsk >> 4, nb = tsk & 15, n = nb * 64 + F.lane, gi = k8 >> 4, cc0 = (k8 & 15) * 8;
            float accw[8];
#pragma unroll
            for (int j = 0; j < 8; ++j) accw[j] = 0.f;
            for (int d = 0; d < 128; ++d) { const float wv = pool_scale[gi * 128 + d] * w_br_pool[(size_t)(gi * 128 + d) * 1024 + n];
#pragma unroll
                for (int j = 0; j < 8; ++j) accw[j] += pool_w[((size_t)gi * 128 + cc0 + j) * 128 + d] * wv; }
            u32x4 o; o.x = cvtpk(accw[0], accw[1]); o.y = cvtpk(accw[2], accw[3]); o.z = cvtpk(accw[4], accw[5]); o.w = cvtpk(accw[6], accw[7]);
            *(u32x4*)(wcat + (size_t)n * 2048 + gi * 128 + cc0) = o; }
    }
    SEAM(0);

    if (IN(1)) {
        if (F.bx == 0) { const int z = F.tid >> 8, n = F.tid & 255; float s = 0.f;
#pragma unroll
            for (int k = 0; k < 16; ++k) s += b1part[(z * 16 + k) * 256 + n];
            bias1[z * 256 + n] = s; }
        pg8::Gemm g{hbuf, win_t, 1024, 1024}; pg8::SchedGrid S{64, 24, F.G, F.bx, 16};
        pg8::EpiIn E{upool, q_buf, qx_buf, gbr, gnsa, kvs, rope};
        pg8::gemm_phase<pg8::EpiIn, pg8::SchedGrid, true>(F.lds, g, S, E);
    }
    SEAM(1);

    if (IN(2)) {
        if (F.bx < 16) {
            pg8::Gemm g{kvs, wc1_t, 1024, 2048}; pg8::SchedCmp S{16, F.bx};
            pg8::EpiCmp E{hid, bias1};
            pg8::gemm_phase<pg8::EpiCmp, pg8::SchedCmp, true>(F.lds, g, S, E);
            VM_WAIT(); __syncthreads();
            const int z = F.bx >> 3, R0 = F.bx * 256 + 32 * F.wave, r32 = F.lane & 31, h = F.lane >> 5;
            f32x16 C[2]; C[0] = (f32x16){0.f,0.f,0.f,0.f,0.f,0.f,0.f,0.f,0.f,0.f,0.f,0.f,0.f,0.f,0.f,0.f}; C[1] = C[0];
#pragma unroll 4
            for (int s = 0; s < 16; ++s) {
                const bf16x8 af = *(const bf16x8*)(hid + (size_t)(R0 + r32) * 256 + 16 * s + 8 * h);
#pragma unroll
                for (int nb = 0; nb < 2; ++nb) { const bf16x8 bfr = *(const bf16x8*)(wc2t + ((size_t)z * 64 + nb * 32 + r32) * 256 + 16 * s + 8 * h);
                    C[nb] = __builtin_amdgcn_mfma_f32_32x32x16_bf16(af, bfr, C[nb], 0, 0, 0); }
            }
#pragma unroll
            for (int nb = 0; nb < 2; ++nb)
#pragma unroll
                for (int r = 0; r < 16; ++r) {
                    const int R = R0 + krow(r, h), bgi = (R >> 9) & 3, i = R & 511, n = nb * 32 + r32;
                    if (z == 0) kc[((size_t)bgi * 512 + i) * 64 + n] = f2bf(C[nb][r]);
                    else { const int kk = i & 31, pos = (kk & 16) | (kk & 3) | (((kk >> 3) & 1) << 2) | (((kk >> 2) & 1) << 3);
                           vct[(((size_t)bgi * 16 + (i >> 5)) * 64 + n) * 32 + pos] = f2bf(C[nb][r]); }
                }
        } else if (F.bx < 24) {
            pg8::Gemm g{memn, wmem_t, 1024, 1024}; pg8::SchedGrid S{2, 4, 8, F.bx - 16, 16};
            pg8::EpiMemKV E{memk, memvt};
            pg8::gemm_phase<pg8::EpiMemKV, pg8::SchedGrid, true>(F.lds, g, S, E);
        } else {
            const int nthr = (F.G - 24) * 512;
            for (int i = (F.bx - 24) * 512 + F.tid; i < MTOK * 64; i += nthr) {
                const int row = i >> 6, o = i & 63, t = row & 8191, wsz = 2 << (o >> 4);
                const int cnt = (t + 1) < wsz ? (t + 1) : wsz;
                float s[8];
#pragma unroll
                for (int e = 0; e < 8; ++e) s[e] = 0.f;
                u32x4 cur = (u32x4){0u, 0u, 0u, 0u};
                for (int k = 0; k < cnt; ++k) { const u32x4 v = *(const u32x4*)(upool + (size_t)(row - k) * 512 + o * 8); if (k == 0) cur = v;
                    s[0] += bflo(v.x); s[1] += bfhi(v.x); s[2] += bflo(v.y); s[3] += bfhi(v.y); s[4] += bflo(v.z); s[5] += bfhi(v.z); s[6] += bflo(v.w); s[7] += bfhi(v.w); }
                const float ic = 1.0f / (float)cnt;
                u32x4 w; w.x = cvtpk(s[0] * ic - bflo(cur.x), s[1] * ic - bfhi(cur.x)); w.y = cvtpk(s[2] * ic - bflo(cur.y), s[3] * ic - bfhi(cur.y));
                w.z = cvtpk(s[4] * ic - bflo(cur.z), s[5] * ic - bfhi(cur.z)); w.w = cvtpk(s[6] * ic - bflo(cur.w), s[7] * ic - bfhi(cur.w));
                *(u32x4*)(acat + (size_t)row * 2048 + o * 8) = w;
            }
        }
    }
    SEAM(2);

    if (IN(3)) {
        for (int v = F.vcu; v < 256; v += F.G) {
            const int bg = v >> 6, pi = v & 63;
#ifndef NO_NSA
            for (int uu = 0; uu < 2; ++uu) nsa_unit(F, bg >> 1, bg & 1, uu ? 127 - pi : pi, q_buf, gnsa, kc, vct, kvs, acat);
#endif
#ifndef NO_MEM
            mem_unit(F, v >> 7, (v >> 5) & 3, v & 31, qx_buf, memk, memvt, acat);
#endif
        }
    }
    SEAM(3);

    if (IN(4)) {
        pg8::Gemm g{acat, wcat, 2048, 2048}; pg8::SchedCat S{F.G, F.bx};
        pg8::EpiGate E{gbr, out, ybuf};
        pg8::gemm_phase<pg8::EpiGate, pg8::SchedCat, true>(F.lds, g, S, E);
    }
    SEAM(4);

    if (IN(5)) {
        pg8::Gemm g{ybuf, wout_t, 1024, 1024}; pg8::SchedGrid S{64, 4, F.G, F.bx, 16};
        pg8::EpiF32 E{out, 1024};
        pg8::gemm_phase<pg8::EpiF32, pg8::SchedGrid, true>(F.lds, g, S, E);
    }
    SEAM(5);

    if (IN(6)) {
        for (int m = gw; m < MTOK; m += NGW) {
            f32x4* yr = (f32x4*)(out + (size_t)m * DM) + F.lane; const f32x4* xr = (const f32x4*)(x + (size_t)m * DM) + F.lane;
            const f32x4* g1 = (const f32x4*)post_mix_g + F.lane; const f32x4* g2 = (const f32x4*)pre_ffn_g + F.lane;
            f32x4 v[4]; float s = 0.f;
#pragma unroll
            for (int j = 0; j < 4; ++j) { v[j] = yr[64 * j]; s += (v[j].x * v[j].x + v[j].y * v[j].y) + (v[j].z * v[j].z + v[j].w * v[j].w); }
            const float rstd = 1.0f / sqrtf(wave_sum(s) * (1.f / DM) + EPS); float s2 = 0.f;
#pragma unroll
            for (int j = 0; j < 4; ++j) { v[j] = xr[64 * j] + v[j] * rstd * g1[64 * j]; yr[64 * j] = v[j]; s2 += (v[j].x * v[j].x + v[j].y * v[j].y) + (v[j].z * v[j].z + v[j].w * v[j].w); }
            const float rstd2 = 1.0f / sqrtf(wave_sum(s2) * (1.f / DM) + EPS);
            u32x2* o8 = (u32x2*)(hbuf + (size_t)m * DM) + F.lane;
#pragma unroll
            for (int j = 0; j < 4; ++j) { const f32x4 gg = g2[64 * j]; u32x2 w; w.x = cvtpk(v[j].x * rstd2 * gg.x, v[j].y * rstd2 * gg.y); w.y = cvtpk(v[j].z * rstd2 * gg.z, v[j].w * rstd2 * gg.w); o8[64 * j] = w; }
        }
    }
    SEAM(6);

    if (IN(7)) {
        pg8::Gemm g{hbuf, wup_t, 1024, 1024}; pg8::SchedGrid S{64, 22, F.G, F.bx, 16};
        pg8::EpiConv E{a2, halo, conv_w, conv_b};
        pg8::gemm_phase<pg8::EpiConv, pg8::SchedGrid, true>(F.lds, g, S, E);
    }
    SEAM(7);

    if (IN(8)) {
        for (int i = gt; i < 256 * 2 * (DFF / 4); i += NGT) {
            const int c4 = i % (DFF / 4), rr = (i / (DFF / 4)) & 1, k = i / (2 * (DFF / 4)), ch = c4 * 4;
            const int gcol = 256 * (ch >> 7) + (ch & 127);
            const bool first = (k & 127) == 0;
            float cv[2][4];
#pragma unroll
            for (int bj = 0; bj < 2; ++bj) {
                const int ci = bj * DFF + ch; const bf16* hp = halo + (size_t)k * 4 * DFF2 + gcol + bj * 128;
                const f32x4 w0 = *(const f32x4*)(conv_w + ci), w1 = *(const f32x4*)(conv_w + DFF2 + ci), w2 = *(const f32x4*)(conv_w + 2 * DFF2 + ci), bb = *(const f32x4*)(conv_b + ci);
                u32x2 um2 = *(const u32x2*)(hp + (size_t)(rr + 0) * DFF2), um1 = *(const u32x2*)(hp + (size_t)(rr + 1) * DFF2), u0 = *(const u32x2*)(hp + (size_t)(rr + 2) * DFF2);
                if (first && rr == 0) { um2 = (u32x2){0u, 0u}; um1 = (u32x2){0u, 0u}; }
                if (first && rr == 1) { um2 = (u32x2){0u, 0u}; }
                cv[bj][0] = bb[0] + w0[0] * bflo(um2.x) + w1[0] * bflo(um1.x) + w2[0] * bflo(u0.x);
                cv[bj][1] = bb[1] + w0[1] * bfhi(um2.x) + w1[1] * bfhi(um1.x) + w2[1] * bfhi(u0.x);
                cv[bj][2] = bb[2] + w0[2] * bflo(um2.y) + w1[2] * bflo(um1.y) + w2[2] * bflo(u0.y);
                cv[bj][3] = bb[3] + w0[3] * bfhi(um2.y) + w1[3] * bfhi(um1.y) + w2[3] * bfhi(u0.y);
            }
            u32x2 w; w.x = cvtpk(gelu_tanh(cv[0][0]) * cv[1][0], gelu_tanh(cv[0][1]) * cv[1][1]); w.y = cvtpk(gelu_tanh(cv[0][2]) * cv[1][2], gelu_tanh(cv[0][3]) * cv[1][3]);
            *(u32x2*)(a2 + (size_t)(64 * k + rr) * DFF + ch) = w;
        }
    }
    SEAM(8);

    if (IN(9)) {
        pg8::Gemm g{a2, wdown_t, DFF, DFF}; pg8::SchedGrid S{64, 4, F.G, F.bx, 44};
        pg8::EpiF32 E{fbuf, 1024};
        pg8::gemm_phase<pg8::EpiF32, pg8::SchedGrid, true>(F.lds, g, S, E);
    }
    SEAM(9);

    if (IN(10)) {
        for (int m = gw; m < MTOK; m += NGW) {
            f32x4* orow = (f32x4*)(out + (size_t)m * DM) + F.lane; const f32x4* fr_ = (const f32x4*)(fbuf + (size_t)m * DM) + F.lane;
            const f32x4* g4 = (const f32x4*)post_ffn_g + F.lane;
            f32x4 v[4]; float s = 0.f;
#pragma unroll
            for (int j = 0; j < 4; ++j) { v[j] = fr_[64 * j]; s += (v[j].x * v[j].x + v[j].y * v[j].y) + (v[j].z * v[j].z + v[j].w * v[j].w); }
            const float rstd = 1.0f / sqrtf(wave_sum(s) * (1.f / DM) + EPS);
#pragma unroll
            for (int j = 0; j < 4; ++j) orow[64 * j] = orow[64 * j] + v[j] * rstd * g4[64 * j];
        }
    }
#undef IN
#undef SEAM
}

extern "C" void kernel_launch(void* const* d_in, const int* in_sizes, int n_in, void* d_out, int out_size, void* d_ws, size_t ws_size, hipStream_t stream) {
    static int grid = 0;
    if (grid == 0) {
        if (n_in != 23 || in_sizes[0] != MTOK * DM || out_size != MTOK * DM || ws_size < WS_END) {
            fprintf(stderr, "kernel_launch: unexpected problem shape (n_in %d, in0 %d, out %d, ws %zu); nothing launched\n", n_in, n_in > 0 ? in_sizes[0] : -1, out_size, ws_size); grid = -1; return; }
        int dev = 0, cus = 0, per_cu = 0;
        if (hipGetDevice(&dev) != hipSuccess || hipDeviceGetAttribute(&cus, hipDeviceAttributeMultiprocessorCount, dev) != hipSuccess) { grid = -1; return; }
        if (hipFuncSetAttribute((const void*)mk_fwd, hipFuncAttributeMaxDynamicSharedMemorySize, LDS_BYTES) != hipSuccess) { fprintf(stderr, "kernel_launch: hipFuncSetAttribute failed\n"); grid = -1; return; }
        if (hipOccupancyMaxActiveBlocksPerMultiprocessor(&per_cu, (const void*)mk_fwd, 512, LDS_BYTES) != hipSuccess || per_cu < 1) {
            fprintf(stderr, "kernel_launch: occupancy query reports %d workgroups per CU; nothing launched\n", per_cu); (void)hipGetLastError(); grid = -1; return; }
        grid = cus;
    }
    if (grid < 0) return;
    (void)hipMemsetAsync((char*)d_ws + WS_CTL, 0, CTL_ZERO_BYTES, stream);
    Args a{};
    for (int i = 0; i < 23; ++i) a.in[i] = (const float*)d_in[i];
    a.out = (float*)d_out; a.ws = (unsigned char*)d_ws;
    for (int i = 0; i < 8; ++i) a.invf[i] = (float)pow(500000.0, -0.125 * (double)i);
#if MK_LAUNCHES == 1
    a.ph_lo = 0; a.ph_hi = NPHASE;
    hipLaunchKernelGGL(mk_fwd, dim3(grid), dim3(512), LDS_BYTES, stream, a);
#else
    for (int p = 0; p < NPHASE; ++p) { a.ph_lo = p; a.ph_hi = p + 1; hipLaunchKernelGGL(mk_fwd, dim3(grid), dim3(512), LDS_BYTES, stream, a); }
#endif
}
```

```cpp
#include <hip/hip_runtime.h>
#include <cstdio>
#include <cstdint>
#include <cmath>

#ifndef P3REP
#define P3REP 0
#endif
#ifndef MK_LAUNCHES
#define MK_LAUNCHES 1
#endif

#define LAS __attribute__((address_space(3)))
#define GAS __attribute__((address_space(1)))
typedef unsigned short bf16;
typedef short bf16x8 __attribute__((ext_vector_type(8)));
typedef float f32x4 __attribute__((ext_vector_type(4)));
typedef float f32x16 __attribute__((ext_vector_type(16)));
typedef unsigned u32x4 __attribute__((ext_vector_type(4)));
typedef unsigned u32x2 __attribute__((ext_vector_type(2)));
typedef float f32x2_t __attribute__((ext_vector_type(2)));
typedef __bf16 bf16x2_t __attribute__((ext_vector_type(2)));

constexpr int BATCH = 2, SEQ = 8192, DM = 1024, MTOK = BATCH * SEQ;
constexpr int DIN = 5936, DINP = 6144;
constexpr int DFF = 2816, DFF2 = 5632;
constexpr float EPS = 1e-6f;
constexpr float LOG2E = 1.4426950408889634f;
constexpr float QSCALE = 0.125f * LOG2E;
constexpr float QXSCALE = 0.08838834764831845f * LOG2E;

constexpr size_t MiB = 1u << 20;
constexpr size_t WS_CTL = 0, CTL_ZERO_BYTES = 1 * MiB;
constexpr size_t WS_ROPE = 1 * MiB;
constexpr size_t WS_BIAS1 = 2 * MiB;
constexpr size_t WS_B1PART = 2 * MiB + 16 * 1024;
constexpr size_t WS_WC2T = 2 * MiB + 64 * 1024;
constexpr size_t WS_KC = 2 * MiB + 256 * 1024;
constexpr size_t WS_VCT = 2 * MiB + 512 * 1024;
constexpr size_t WS_MEMN = 3 * MiB;
constexpr size_t WS_MEMK = 4 * MiB;
constexpr size_t WS_MEMVT = 4 * MiB + 512 * 1024;
constexpr size_t WS_HID = 5 * MiB;
constexpr size_t WS_GNSA = 7 * MiB;
constexpr size_t WS_WCAT = 12 * MiB;
constexpr size_t WS_WOUT = 16 * MiB;
constexpr size_t WS_WUP = 18 * MiB;
constexpr size_t WS_WDOWN = 29 * MiB;
constexpr size_t WS_WMEM = 35 * MiB;
constexpr size_t WS_WC1 = 37 * MiB;
constexpr size_t WS_WIN = 39 * MiB;
constexpr size_t WS_KV = 51 * MiB;
constexpr size_t WS_Y = 39 * MiB;
constexpr size_t WS_F = 39 * MiB;
constexpr size_t WS_ACAT = 75 * MiB;
constexpr size_t WS_GBR = 139 * MiB;
constexpr size_t WS_A2 = 139 * MiB;
constexpr size_t WS_HALO = 227 * MiB;
constexpr size_t WS_END = 240 * MiB;
constexpr size_t KVSLAB = 2097152;

constexpr int CW_TMO = 0, CW_CODE = 1, CW_BAR = 4096;

constexpr int RING_BYTES = 131072;
constexpr int LDSCTL_OFF = RING_BYTES, MISC_OFF = LDSCTL_OFF + 320;
constexpr int LDS_BYTES = 147456;
constexpr int L_KB = 0, L_VB = 9216, L_IMP = 19456, L_SEL = 52480, L_SELCNT = 56576, L_YT = 56832;
constexpr int YT_STRIDE = 1040;
constexpr int IMP_STRIDE = 129;

__device__ __forceinline__ unsigned cvtpk(float lo, float hi) { f32x2_t v = {lo, hi}; bf16x2_t b = __builtin_convertvector(v, bf16x2_t); return __builtin_bit_cast(unsigned, b); }
__device__ __forceinline__ float bf2f(unsigned short b) { return __uint_as_float((unsigned)b << 16); }
__device__ __forceinline__ float bflo(unsigned w) { return __uint_as_float(w << 16); }
__device__ __forceinline__ float bfhi(unsigned w) { return __uint_as_float(w & 0xffff0000u); }
__device__ __forceinline__ unsigned short f2bf(float f) { return (unsigned short)(cvtpk(f, 0.f) & 0xffffu); }
__device__ __forceinline__ float wave_sum(float v) {
#pragma unroll
    for (int o = 1; o < 64; o <<= 1) v += __shfl_xor(v, o);
    return v;
}
__device__ __forceinline__ float sigmoidf_(float x) { return 1.0f / (1.0f + __builtin_amdgcn_exp2f(-x * LOG2E)); }
__device__ __forceinline__ float gelu_tanh(float x) {
    const float u2 = 1.5957691216057308f * (x + 0.044715f * x * x * x);
    return x / (1.0f + __builtin_amdgcn_exp2f(-u2 * LOG2E));
}
#define LDS_WAIT() asm volatile("s_waitcnt lgkmcnt(0)" ::: "memory")
#define VM_WAIT() asm volatile("s_waitcnt vmcnt(0)" ::: "memory")

namespace pg8 {
constexpr int BM = 256, BK = 64, HALF = 128, HTB = HALF * BK * 2, STAGE_BYTES = 8 * HTB, NXCD = 8, WGM = 8;
__host__ __device__ __forceinline__ int lds_byte(int r, int c) { const int st = (r >> 4) * 2 + (c >> 5), rr = r & 15, cc = c & 31, ob = rr * 64 + cc * 2; return st * 1024 + (ob ^ (((ob >> 9) & 1) << 5)); }
__host__ __device__ __forceinline__ void stage_rc(int b, int& R, int& C) { const int st = b / 1024, sb = b % 1024, swz = sb ^ (((sb >> 9) & 1) << 5); R = (st >> 1) * 16 + swz / 64; C = (st & 1) * 32 + (swz % 64) / 2; }
__host__ __device__ __forceinline__ int perm32(int rho) { const int n = rho >> 4, i = rho & 15; return 8 * (i >> 2) + 4 * n + (i & 3); }

struct Unit { int pm, pn, koff, nt, tag, boff; };
struct Gemm { const bf16* A; const bf16* Bt; int lda, ldb; };

__device__ __forceinline__ void tile_of(int wgid_in, int nM, int nN, int& pm, int& pn) {
    const int nwg = nM * nN; int wgid = wgid_in;
    { const int q = nwg / NXCD, r = nwg % NXCD, xcd = wgid % NXCD, off = wgid / NXCD; wgid = (xcd < r ? xcd * (q + 1) : r * (q + 1) + (xcd - r) * q) + off; }
    const int nig = WGM * nN, gid = wgid / nig, fm = gid * WGM, gsz = (nM - fm) < WGM ? (nM - fm) : WGM;
    pm = fm + ((wgid % nig) % gsz); pn = (wgid % nig) / gsz;
}
struct SchedGrid {
    int nM, nN, G, c, nt;
    __device__ __forceinline__ bool next(int i, Unit& u) const {
        const long L = (long)i * G + c; if (L >= (long)nM * nN) return false;
        tile_of((int)L, nM, nN, u.pm, u.pn); u.koff = 0; u.nt = nt; u.tag = 0; u.boff = 0; return true;
    }
};
struct SchedCat {
    int G, c;
    __device__ __forceinline__ bool next(int i, Unit& u) const {
        const int br = i % 3; const long L = (long)(i / 3) * G + c; if (L >= 256) return false;
        tile_of((int)L, 64, 4, u.pm, u.pn); u.koff = br == 0 ? 0 : (br == 1 ? 512 : 1536); u.nt = br == 1 ? 16 : 8; u.tag = br; u.boff = 0; return true;
    }
};
struct SchedCmp {
    int G, c;
    __device__ __forceinline__ bool next(int i, Unit& u) const {
        const long L = (long)i * G + c; if (L >= 16) return false;
        u.pm = (int)L; u.pn = 0; u.koff = 0; u.nt = 32; u.tag = u.pm >> 3; u.boff = u.tag * 256 * 2048; return true;
    }
};

#define PG8_SA(b, h) (((b) * 2 + (h)) * HTB)
#define PG8_SB(b, h) ((4 + (b) * 2 + (h)) * HTB)
#define PG8_STAGE(bufoff, gbase, voff) do { _Pragma("unroll") for (int _i = 0; _i < 2; ++_i) \
        __builtin_amdgcn_global_load_lds((const unsigned*)((const char*)(gbase) + (voff)[_i]), (LAS unsigned*)(lds + (bufoff) + ldsw + _i * 8192), 16, 0, 0); } while (0)
#define PG8_LDA(dst, b, h) do { _Pragma("unroll") for (int m = 0; m < 4; ++m) _Pragma("unroll") for (int k = 0; k < 2; ++k) dst[m][k] = *(const LAS bf16x8*)(lds + PG8_SA(b, h) + aoff + m * 2048 + k * 1024); } while (0)
#define PG8_LDB(dst, b, h) do { _Pragma("unroll") for (int n = 0; n < 2; ++n) _Pragma("unroll") for (int k = 0; k < 2; ++k) dst[n][k] = *(const LAS bf16x8*)(lds + PG8_SB(b, h) + boff + n * 2048 + k * 1024); } while (0)
#define PG8_MMA(ai, bj, At, Bt) do { __builtin_amdgcn_s_setprio(1); _Pragma("unroll") for (int m = 0; m < 4; ++m) _Pragma("unroll") for (int n = 0; n < 2; ++n) _Pragma("unroll") for (int k = 0; k < 2; ++k) \
        acc[ai][bj][m][n] = __builtin_amdgcn_mfma_f32_16x16x32_bf16(Bt[n][k], At[m][k], acc[ai][bj][m][n], 0, 0, 0); __builtin_amdgcn_s_setprio(0); } while (0)
#define PG8_WAIT_V(n) asm volatile("s_waitcnt vmcnt(" #n ")" ::: "memory")
#define PG8_WAIT_L(n) asm volatile("s_waitcnt lgkmcnt(" #n ")" ::: "memory")
#define PG8_BAR __builtin_amdgcn_s_barrier()
#define PG8_SCHED __builtin_amdgcn_sched_barrier(0)

template <class Epi, class Sched, bool ALIGN_EPI>
__device__ __forceinline__ void gemm_phase(LAS unsigned char* lds, const Gemm g, const Sched& S, const Epi& E) {
    int tid = threadIdx.x; asm volatile("" : "+v"(tid));
    const int wid = __builtin_amdgcn_readfirstlane(tid >> 6), lane = tid & 63, wr = wid >> 2, wc = wid & 3, fr = lane & 15, fq = lane >> 4;
    unsigned voffA[2], voffB[2];
#pragma unroll
    for (int i = 0; i < 2; ++i) { int R, C; stage_rc(tid * 16 + i * 8192, R, C); const int Rb = Epi::PERM ? ((R & ~31) + perm32(R & 31)) : R;
        voffA[i] = (unsigned)(R * g.lda + C) * 2u; voffB[i] = (unsigned)(Rb * g.ldb + C) * 2u; }
    const size_t kstep = (size_t)(BK * 2);
    const size_t hstepA = (size_t)HALF * g.lda * 2, hstepB = (size_t)HALF * g.ldb * 2;
    const unsigned ldsw = (unsigned)wid * 1024u;
    const int aoff = lds_byte(wr * 64 + fr, fq * 8), boff = lds_byte(wc * 32 + fr, fq * 8);
    Unit cur, nxt; int ui = 0;
    if (!S.next(0, cur)) return;
    f32x4 acc[2][2][4][2];
#pragma unroll
    for (int a = 0; a < 2; ++a)
#pragma unroll
        for (int b = 0; b < 2; ++b)
#pragma unroll
            for (int m = 0; m < 4; ++m)
#pragma unroll
                for (int n = 0; n < 2; ++n) acc[a][b][m][n] = (f32x4){0.f, 0.f, 0.f, 0.f};
    bf16x8 At[4][2], B0[2][2], B1[2][2];
    const char* cA = (const char*)g.A + ((size_t)cur.pm * 256 * g.lda + cur.koff) * 2;
    const char* cB = (const char*)g.Bt + ((size_t)cur.boff + (size_t)cur.pn * 256 * g.ldb + cur.koff) * 2;
    int nt = cur.nt;
    PG8_STAGE(PG8_SB(0, 0), cB, voffB); PG8_STAGE(PG8_SB(0, 1), cB + hstepB, voffB); PG8_STAGE(PG8_SA(0, 0), cA, voffA); PG8_STAGE(PG8_SA(0, 1), cA + hstepA, voffA);
    if (wr == 1) PG8_BAR;
    PG8_WAIT_V(2); PG8_BAR;
    PG8_STAGE(PG8_SB(1, 0), cB + kstep, voffB); PG8_STAGE(PG8_SA(1, 0), cA + kstep, voffA); PG8_STAGE(PG8_SB(1, 1), cB + hstepB + kstep, voffB);
    PG8_WAIT_V(6); PG8_BAR;
    for (;;) {
        const bool has_next = S.next(ui + 1, nxt);
        const char* nA = has_next ? (const char*)g.A + ((size_t)nxt.pm * 256 * g.lda + nxt.koff) * 2 : cA;
        const char* nB = has_next ? (const char*)g.Bt + ((size_t)nxt.boff + (size_t)nxt.pn * 256 * g.ldb + nxt.koff) * 2 : cB;
        for (int t = 0; t < nt; t += 2) {
            const bool last = (t == nt - 2);
            const char* a1 = cA + (size_t)(t + 1) * kstep;
            const char* a2 = last ? nA : cA + (size_t)(t + 2) * kstep; const char* b2 = last ? nB : cB + (size_t)(t + 2) * kstep;
            const char* a3 = a2 + kstep; const char* b3 = b2 + kstep;
            PG8_LDB(B0, 0, 0); PG8_LDB(B1, 0, 1); PG8_SCHED; PG8_LDA(At, 0, 0); PG8_STAGE(PG8_SA(1, 1), a1 + hstepA, voffA);
            PG8_WAIT_V(8); PG8_WAIT_L(0); PG8_BAR; PG8_MMA(0, 0, At, B0); PG8_MMA(0, 1, At, B1); PG8_BAR; PG8_SCHED;
            PG8_LDA(At, 0, 1); PG8_STAGE(PG8_SB(0, 0), b2, voffB); PG8_STAGE(PG8_SB(0, 1), b2 + hstepB, voffB); PG8_STAGE(PG8_SA(0, 0), a2, voffA);
            PG8_WAIT_V(8); PG8_WAIT_L(0); PG8_BAR; PG8_MMA(1, 0, At, B0); PG8_MMA(1, 1, At, B1); PG8_BAR; PG8_SCHED;
            PG8_LDB(B0, 1, 0); PG8_LDB(B1, 1, 1); PG8_SCHED; PG8_LDA(At, 1, 0); PG8_STAGE(PG8_SA(0, 1), a2 + hstepA, voffA);
            PG8_WAIT_V(8); PG8_WAIT_L(0); PG8_BAR; PG8_MMA(0, 0, At, B0); PG8_MMA(0, 1, At, B1); PG8_BAR; PG8_SCHED;
            PG8_LDA(At, 1, 1); PG8_STAGE(PG8_SB(1, 0), b3, voffB); PG8_STAGE(PG8_SB(1, 1), b3 + hstepB, voffB); PG8_STAGE(PG8_SA(1, 0), a3, voffA);
            PG8_WAIT_V(8); PG8_WAIT_L(0); PG8_BAR; PG8_MMA(1, 0, At, B0); PG8_MMA(1, 1, At, B1); PG8_BAR; PG8_SCHED;
        }
        if constexpr (ALIGN_EPI) { if (wr == 0) PG8_BAR; }
        E(acc, cur, wr, wc, fr, fq);
        if (!has_next) break;
#pragma unroll
        for (int a = 0; a < 2; ++a)
#pragma unroll
            for (int b = 0; b < 2; ++b)
#pragma unroll
                for (int m = 0; m < 4; ++m)
#pragma unroll
                    for (int n = 0; n < 2; ++n) acc[a][b][m][n] = (f32x4){0.f, 0.f, 0.f, 0.f};
        cur = nxt; cA = nA; cB = nB; nt = cur.nt; ++ui;
        if constexpr (ALIGN_EPI) { if (wr == 1) PG8_BAR; }
    }
    PG8_WAIT_V(0);
    if constexpr (!ALIGN_EPI) { if (wr == 0) PG8_BAR; }
    PG8_BAR;
}

struct EpiF32 {
    static constexpr bool PERM = false;
    float* C; int ldc;
    __device__ __forceinline__ void operator()(const f32x4 (&acc)[2][2][4][2], const Unit& u, int wr, int wc, int fr, int fq) const {
        const int row0 = u.pm * BM + wr * 64 + fr, col0 = u.pn * BM + wc * 32 + 4 * fq;
#pragma unroll
        for (int ai = 0; ai < 2; ++ai)
#pragma unroll
            for (int m = 0; m < 4; ++m) { float* rowp = C + (size_t)(row0 + ai * HALF + m * 16) * ldc + col0;
#pragma unroll
                for (int bj = 0; bj < 2; ++bj)
#pragma unroll
                    for (int n = 0; n < 2; ++n) *(f32x4*)(rowp + bj * HALF + n * 16) = acc[ai][bj][m][n]; }
    }
};

struct EpiCmp {
    static constexpr bool PERM = true;
    bf16* H; const float* bias1;
    __device__ __forceinline__ void operator()(const f32x4 (&acc)[2][2][4][2], const Unit& u, int wr, int wc, int fr, int fq) const {
        const int row0 = u.pm * BM + wr * 64 + fr, col0 = wc * 32 + 8 * fq;
        const float* bz = bias1 + u.tag * 256;
#pragma unroll
        for (int bj = 0; bj < 2; ++bj) {
            const f32x4 b0 = *(const f32x4*)(bz + col0 + bj * HALF), b1 = *(const f32x4*)(bz + col0 + bj * HALF + 4);
#pragma unroll
            for (int ai = 0; ai < 2; ++ai)
#pragma unroll
                for (int m = 0; m < 4; ++m) {
                    const f32x4 v0 = acc[ai][bj][m][0] + b0, v1 = acc[ai][bj][m][1] + b1;
                    u32x4 w; w.x = cvtpk(gelu_tanh(v0[0]), gelu_tanh(v0[1])); w.y = cvtpk(gelu_tanh(v0[2]), gelu_tanh(v0[3]));
                    w.z = cvtpk(gelu_tanh(v1[0]), gelu_tanh(v1[1])); w.w = cvtpk(gelu_tanh(v1[2]), gelu_tanh(v1[3]));
                    *(u32x4*)(H + (size_t)(row0 + ai * HALF + m * 16) * 256 + col0 + bj * HALF) = w;
                }
        }
    }
};

struct EpiMemKV {
    static constexpr bool PERM = true;
    bf16* MK; bf16* MVT;
    __device__ __forceinline__ void operator()(const f32x4 (&acc)[2][2][4][2], const Unit& u, int wr, int wc, int fr, int fq) const {
        const int row0 = u.pm * BM + wr * 64 + fr;
#pragma unroll
        for (int bj = 0; bj < 2; ++bj) {
            const int col = u.pn * BM + bj * HALF + wc * 32 + 8 * fq;
            const int kvsel = col >> 9, head = (col >> 7) & 3, d0 = col & 127;
#pragma unroll
            for (int ai = 0; ai < 2; ++ai)
#pragma unroll
                for (int m = 0; m < 4; ++m) {
                    const int row = row0 + ai * HALF + m * 16, b = row >> 8, mm = row & 255;
                    const f32x4 v0 = acc[ai][bj][m][0], v1 = acc[ai][bj][m][1];
                    if (kvsel == 0) {
                        u32x4 w; w.x = cvtpk(v0[0], v0[1]); w.y = cvtpk(v0[2], v0[3]); w.z = cvtpk(v1[0], v1[1]); w.w = cvtpk(v1[2], v1[3]);
                        *(u32x4*)(MK + ((size_t)((b * 4 + head) * 256 + mm)) * 128 + d0) = w;
                    } else {
                        const int kk = mm & 31, pos = (kk & 16) | (kk & 3) | (((kk >> 3) & 1) << 2) | (((kk >> 2) & 1) << 3);
                        bf16* base = MVT + ((size_t)((b * 4 + head) * 8 + (mm >> 5)) * 128 + d0) * 32 + pos;
#pragma unroll
                        for (int e = 0; e < 4; ++e) { base[(size_t)e * 32] = f2bf(v0[e]); base[(size_t)(e + 4) * 32] = f2bf(v1[e]); }
                    }
                }
        }
    }
};

struct EpiIn {
    static constexpr bool PERM = true;
    bf16* upool; bf16* q; bf16* qx; bf16* gbr; float* gnsa; bf16* kv; const float* rope;
    __device__ __forceinline__ void operator()(const f32x4 (&acc_in)[2][2][4][2], const Unit& u, int wr, int wc, int fr, int fq) const {
        const int pn = u.pn, row0 = u.pm * BM + wr * 64 + fr, cl = wc * 32 + 8 * fq;
        const bool rotw = (pn >= 2 && pn < 9) && ((wc & 1) == 0);
#pragma unroll
        for (int ai = 0; ai < 2; ++ai)
#pragma unroll
            for (int m = 0; m < 4; ++m) {
                const int row = row0 + ai * HALF + m * 16;
#pragma unroll
                for (int bj = 0; bj < 2; ++bj) {
                    f32x4 v0 = acc_in[ai][bj][m][0], v1 = acc_in[ai][bj][m][1];
                    const bool rot_here = rotw && (pn < 6 || bj == 0);
                    if (rot_here) {
                        f32x4 y0, y1;
#pragma unroll
                        for (int e = 0; e < 4; ++e) { y0[e] = __shfl_xor(v0[e], 16); y1[e] = __shfl_xor(v1[e], 16); }
                        if (fq < 2) {
                            const f32x4 c0 = *(const f32x4*)(rope + (size_t)row * 16), c1 = *(const f32x4*)(rope + (size_t)row * 16 + 4);
                            const f32x4 s0 = *(const f32x4*)(rope + (size_t)row * 16 + 8), s1 = *(const f32x4*)(rope + (size_t)row * 16 + 12);
                            const float sg = fq == 0 ? -1.f : 1.f;
                            v0 = v0 * c0 + sg * (y0 * s0); v1 = v1 * c1 + sg * (y1 * s1);
                        }
                    }
                    if (pn < 2) {
                        u32x4 w; w.x = cvtpk(v0[0], v0[1]); w.y = cvtpk(v0[2], v0[3]); w.z = cvtpk(v1[0], v1[1]); w.w = cvtpk(v1[2], v1[3]);
                        *(u32x4*)(upool + (size_t)row * 512 + pn * 256 + bj * HALF + cl) = w;
                    } else if (pn < 6) {
                        v0 = v0 * QSCALE; v1 = v1 * QSCALE;
                        u32x4 w; w.x = cvtpk(v0[0], v0[1]); w.y = cvtpk(v0[2], v0[3]); w.z = cvtpk(v1[0], v1[1]); w.w = cvtpk(v1[2], v1[3]);
                        *(u32x4*)(q + (size_t)row * 1024 + (pn - 2) * 256 + bj * HALF + cl) = w;
                    } else if (pn < 9) {
                        const int j = 2 * (pn - 6) + bj, gg = wc >> 1, d0 = (wc & 1) * 32 + 8 * fq, b = row >> 13, t = row & 8191;
                        bf16* slab = kv + (size_t)j * KVSLAB;
                        if (j == 3) {
                            const int kk = t & 63, pos = (kk & 32) | (kk & 3) | (((kk >> 4) & 1) << 2) | (((kk >> 2) & 3) << 3);
                            bf16* base = slab + ((size_t)((b * 2 + gg) * 128 + (t >> 6)) * 64 + d0) * 64 + pos;
#pragma unroll
                            for (int e = 0; e < 4; ++e) { base[(size_t)e * 64] = f2bf(v0[e]); base[(size_t)(e + 4) * 64] = f2bf(v1[e]); }
                        } else if (j == 5) {
                            const int kk = t & 31, pos = (kk & 16) | (kk & 3) | (((kk >> 3) & 1) << 2) | (((kk >> 2) & 1) << 3);
                            bf16* base = slab + ((size_t)((b * 2 + gg) * 256 + (t >> 5)) * 64 + d0) * 32 + pos;
#pragma unroll
                            for (int e = 0; e < 4; ++e) { base[(size_t)e * 32] = f2bf(v0[e]); base[(size_t)(e + 4) * 32] = f2bf(v1[e]); }
                        } else {
                            u32x4 w; w.x = cvtpk(v0[0], v0[1]); w.y = cvtpk(v0[2], v0[3]); w.z = cvtpk(v1[0], v1[1]); w.w = cvtpk(v1[2], v1[3]);
                            *(u32x4*)(slab + ((size_t)((b * 2 + gg) * 8192 + t)) * 64 + d0) = w;
                        }
                    } else if (pn == 9) {
                        const int c0 = bj * HALF + cl;
#pragma unroll
                        for (int e = 0; e < 4; ++e) { if (c0 + e < 48) gnsa[(size_t)row * 48 + c0 + e] = sigmoidf_(v0[e]); if (c0 + 4 + e < 48) gnsa[(size_t)row * 48 + c0 + 4 + e] = sigmoidf_(v1[e]); }
                    } else if (pn < 12) {
                        v0 = v0 * QXSCALE; v1 = v1 * QXSCALE;
                        u32x4 w; w.x = cvtpk(v0[0], v0[1]); w.y = cvtpk(v0[2], v0[3]); w.z = cvtpk(v1[0], v1[1]); w.w = cvtpk(v1[2], v1[3]);
                        *(u32x4*)(qx + (size_t)row * 512 + (pn - 10) * 256 + bj * HALF + cl) = w;
                    } else {
                        u32x4 w; w.x = cvtpk(sigmoidf_(v0[0]), sigmoidf_(v0[1])); w.y = cvtpk(sigmoidf_(v0[2]), sigmoidf_(v0[3]));
                        w.z = cvtpk(sigmoidf_(v1[0]), sigmoidf_(v1[1])); w.w = cvtpk(sigmoidf_(v1[2]), sigmoidf_(v1[3]));
                        *(u32x4*)(gbr + (size_t)row * 3072 + (pn - 12) * 256 + bj * HALF + cl) = w;
                    }
                }
            }
    }
};

struct EpiGate {
    static constexpr bool PERM = true;
    const bf16* gbr; float* Y32; bf16* Y;
    __device__ __forceinline__ void operator()(const f32x4 (&acc)[2][2][4][2], const Unit& u, int wr, int wc, int fr, int fq) const {
        const int row0 = u.pm * BM + wr * 64 + fr, br = u.tag;
#pragma unroll
        for (int ai = 0; ai < 2; ++ai)
#pragma unroll
            for (int m = 0; m < 4; ++m) {
                const int row = row0 + ai * HALF + m * 16;
#pragma unroll
                for (int bj = 0; bj < 2; ++bj) {
                    const int col = u.pn * BM + bj * HALF + wc * 32 + 8 * fq;
                    const u32x4 gw = *(const u32x4*)(gbr + (size_t)row * 3072 + br * 1024 + col);
                    f32x4 v0 = acc[ai][bj][m][0], v1 = acc[ai][bj][m][1];
                    v0[0] *= bflo(gw.x); v0[1] *= bfhi(gw.x); v0[2] *= bflo(gw.y); v0[3] *= bfhi(gw.y);
                    v1[0] *= bflo(gw.z); v1[1] *= bfhi(gw.z); v1[2] *= bflo(gw.w); v1[3] *= bfhi(gw.w);
                    float* yp = Y32 + (size_t)row * 1024 + col;
                    if (br != 0) { v0 = v0 + *(const f32x4*)yp; v1 = v1 + *(const f32x4*)(yp + 4); }
                    if (br != 2) { *(f32x4*)yp = v0; *(f32x4*)(yp + 4) = v1; }
                    else { u32x4 w; w.x = cvtpk(v0[0], v0[1]); w.y = cvtpk(v0[2], v0[3]); w.z = cvtpk(v1[0], v1[1]); w.w = cvtpk(v1[2], v1[3]);
                           *(u32x4*)(Y + (size_t)row * 1024 + col) = w; }
                }
            }
    }
};

struct EpiConv {
    static constexpr bool PERM = true;
    bf16* A2; bf16* halo; const float* cw; const float* cb;
    __device__ __forceinline__ void operator()(const f32x4 (&acc)[2][2][4][2], const Unit& u, int wr, int wc, int fr, int fq) const {
        const int lane = threadIdx.x & 63;
        const int src1 = (lane & 48) | ((fr - 1) & 15), src2 = (lane & 48) | ((fr - 2) & 15);
        const int chb = u.pn * 128 + wc * 32 + 8 * fq;
        const int ncol0 = u.pn * 256 + wc * 32 + 8 * fq;
#pragma unroll
        for (int n = 0; n < 2; ++n) {
            const int ch = chb + 4 * n;
            f32x4 w0[2], w1[2], w2[2], bb[2];
#pragma unroll
            for (int bj = 0; bj < 2; ++bj) { const int ci = bj * DFF + ch;
                w0[bj] = *(const f32x4*)(cw + ci); w1[bj] = *(const f32x4*)(cw + DFF2 + ci); w2[bj] = *(const f32x4*)(cw + 2 * DFF2 + ci); bb[bj] = *(const f32x4*)(cb + ci); }
#pragma unroll
            for (int ai = 0; ai < 2; ++ai) {
                const int kk = 4 * u.pm + 2 * ai + wr;
#pragma unroll
                for (int m = 0; m < 4; ++m) {
                    const int row = kk * 64 + m * 16 + fr;
                    f32x4 cv[2];
#pragma unroll
                    for (int bj = 0; bj < 2; ++bj) {
                        const f32x4 cur = acc[ai][bj][m][n];
                        const f32x4 prv = m > 0 ? acc[ai][bj][m - 1][n] : (f32x4){0.f, 0.f, 0.f, 0.f};
                        f32x4 u1, u2;
#pragma unroll
                        for (int e = 0; e < 4; ++e) {
                            const float d1 = fr == 15 ? prv[e] : cur[e];
                            const float d2 = fr >= 14 ? prv[e] : cur[e];
                            u1[e] = __shfl(d1, src1); u2[e] = __shfl(d2, src2);
                        }
                        cv[bj] = bb[bj] + w0[bj] * u2 + w1[bj] * u1 + w2[bj] * cur;
                        if ((m == 3 && fr >= 14) || (m == 0 && fr < 2)) {
                            const int hk = m == 3 ? kk + 1 : kk, hr = m == 3 ? fr - 14 : 2 + fr;
                            u32x2 w; w.x = cvtpk(cur[0], cur[1]); w.y = cvtpk(cur[2], cur[3]);
                            *(u32x2*)(halo + ((size_t)(hk * 4 + hr)) * DFF2 + ncol0 + bj * HALF + 4 * n) = w;
                        }
                    }
                    if (!(m == 0 && fr < 2)) {
                        u32x2 w; w.x = cvtpk(gelu_tanh(cv[0][0]) * cv[1][0], gelu_tanh(cv[0][1]) * cv[1][1]);
                        w.y = cvtpk(gelu_tanh(cv[0][2]) * cv[1][2], gelu_tanh(cv[0][3]) * cv[1][3]);
                        *(u32x2*)(A2 + (size_t)row * DFF + ch) = w;
                    }
                }
            }
        }
    }
};
}

typedef GAS unsigned gu32;
#define RLX_AGENT __ATOMIC_RELAXED, __HIP_MEMORY_SCOPE_AGENT
#define XB_TMO      128
#define XB_XCNT(j)  (256  + 64 * (j))
#define XB_XSUB(j)  (1280 + 64 * (j))
#define XB_XGEN(j)  (2304 + 64 * (j))
#define XB_TOP      3328
#define XB_TOPGEN   3392
#define XCD_BAR_WORDS 3456
#define XB_SPIN_CAP (1u << 22)
__device__ __forceinline__ unsigned xb_ld(unsigned* p)              { return __hip_atomic_load(p, __ATOMIC_RELAXED, __HIP_MEMORY_SCOPE_AGENT); }
__device__ __forceinline__ unsigned xb_add(unsigned* p, unsigned v) { return __hip_atomic_fetch_add(p, v, __ATOMIC_RELAXED, __HIP_MEMORY_SCOPE_AGENT); }
__device__ __forceinline__ unsigned xb_xcc_id() { return (unsigned)__builtin_amdgcn_s_getreg((3 << 11) | 20) & 0xFu; }
#define XB_SPIN(cond, bar) do { unsigned _sp = 0; while (cond) { __builtin_amdgcn_s_sleep(1); \
    if ((++_sp & 255u) == 0u) { if (xb_ld(&(bar)[XB_TMO])) break; if (_sp > XB_SPIN_CAP) { atomicAdd(&(bar)[XB_TMO], 1u); break; } } } } while (0)
struct XcdBarrier { unsigned* bar; unsigned x; volatile LAS unsigned* st; };
__device__ __forceinline__ XcdBarrier xcd_barrier_post(unsigned* bar, volatile LAS unsigned* st) {
    XcdBarrier b; b.bar = bar; b.x = xb_xcc_id(); b.st = st;
    if (threadIdx.x == 0) (void)xb_add(&bar[XB_XCNT(b.x)], 1u);
    return b;
}
__device__ __forceinline__ void xcd_barrier_complete(unsigned* bar, unsigned x, unsigned& nloc, unsigned& nx) {
    const unsigned G = gridDim.x * gridDim.y * gridDim.z;
    unsigned sum, cnt, mine, sp = 0u;
    for (;;) {
        sum = 0u; cnt = 0u; mine = 0u;
#pragma unroll
        for (unsigned j = 0; j < 16; ++j) { const unsigned c = xb_ld(&bar[XB_XCNT(j)]); sum += c; cnt += (c > 0u) ? 1u : 0u; mine = (j == x) ? c : mine; }
        if (sum == G) break;
        __builtin_amdgcn_s_sleep(1);
        if ((++sp & 255u) == 0u) { if (xb_ld(&bar[XB_TMO])) break; if (sp > XB_SPIN_CAP) { atomicAdd(&bar[XB_TMO], 1u); break; } }
    }
    nloc = mine > 0u ? mine : 1u; nx = cnt > 0u ? cnt : 1u;
}
__device__ __forceinline__ void xcd_barrier(const XcdBarrier& b) {
    asm volatile("s_waitcnt vmcnt(0)" ::: "memory");
    __syncthreads();
    if (threadIdx.x == 0) {
        unsigned* bar = b.bar;
        __builtin_amdgcn_s_waitcnt(0);
        unsigned nloc = b.st[0], nx = b.st[1];
        if (nloc == 0u) { xcd_barrier_complete(bar, b.x, nloc, nx); b.st[0] = nloc; b.st[1] = nx; }
        const unsigned old = xb_add(&bar[XB_XSUB(b.x)], 1u);
        const unsigned gen = old / nloc;
        if (old + 1u == (gen + 1u) * nloc) {
            __builtin_amdgcn_fence(__ATOMIC_RELEASE, "agent");
            asm volatile("s_waitcnt vmcnt(0)" ::: "memory");
            const unsigned og = xb_add(&bar[XB_TOP], 1u);
            const unsigned tg = og / nx;
            if (og + 1u == (tg + 1u) * nx) xb_add(&bar[XB_TOPGEN], 1u);
            else XB_SPIN(xb_ld(&bar[XB_TOPGEN]) == tg, bar);
            __builtin_amdgcn_fence(__ATOMIC_ACQUIRE, "agent");
            xb_add(&bar[XB_XGEN(b.x)], 1u);
            asm volatile("s_waitcnt vmcnt(0)" ::: "memory");
        } else {
            XB_SPIN(xb_ld(&bar[XB_XGEN(b.x)]) == gen, bar);
            __builtin_amdgcn_fence(__ATOMIC_ACQUIRE, "agent");
            asm volatile("s_waitcnt vmcnt(0)" ::: "memory");
        }
    }
    __syncthreads();
}

struct Args {
    const float* in[23]; float* out; unsigned char* ws;
    float invf[8];
    int ph_lo, ph_hi;
};

struct Frame {
    LAS unsigned char* lds;
    int tid, lane, wave, vcu, G, bx;
};

template <class Map>
__device__ __forceinline__ void transpose_item(const float* W, int N, bf16* WT, int ldt, int koff, LAS float* scr, int nblk, int item, int lane, Map map) {
    const int kb = item / nblk, nb = item % nblk, k0 = 64 * kb, n0 = 32 * nb;
    const int sc = map(n0 + (lane & 31));
#pragma unroll 8
    for (int i = 0; i < 32; ++i) { const int kk = 2 * i + (lane >> 5); scr[kk * 33 + (lane & 31)] = sc >= 0 ? W[(size_t)(k0 + kk) * N + sc] : 0.f; }
    LDS_WAIT(); asm volatile("" ::: "memory");
    const int c = lane & 7;
#pragma unroll
    for (int j = 0; j < 4; ++j) { const int n = (lane >> 3) + 8 * j; const LAS float* s = scr + (8 * c) * 33 + n;
        u32x4 o; o.x = cvtpk(s[0 * 33], s[1 * 33]); o.y = cvtpk(s[2 * 33], s[3 * 33]); o.z = cvtpk(s[4 * 33], s[5 * 33]); o.w = cvtpk(s[6 * 33], s[7 * 33]);
        *(u32x4*)(WT + (size_t)(n0 + n) * ldt + koff + k0 + 8 * c) = o; }
    LDS_WAIT(); asm volatile("" ::: "memory");
}
struct MapId { __device__ __forceinline__ int operator()(int n) const { return n; } };
struct MapIn { __device__ __forceinline__ int operator()(int n) const { return n < 2352 ? n : (n < 2560 ? -1 : n - 208); } };
struct MapUp { __device__ __forceinline__ int operator()(int n) const { const int pn = n >> 8, r = n & 255; return r < 128 ? pn * 128 + r : DFF + pn * 128 + r - 128; } };

__device__ __forceinline__ void rms_row_to_bf16(const float* xrow, const float* g, bf16* orow, int lane) {
    const f32x4* xr = (const f32x4*)xrow + lane; const f32x4* gr = (const f32x4*)g + lane;
    f32x4 v[4]; float s = 0.f;
#pragma unroll
    for (int j = 0; j < 4; ++j) { v[j] = xr[64 * j]; s += (v[j].x * v[j].x + v[j].y * v[j].y) + (v[j].z * v[j].z + v[j].w * v[j].w); }
    const float rstd = 1.0f / sqrtf(wave_sum(s) * (1.f / DM) + EPS);
    u32x2* o8 = (u32x2*)orow + lane;
#pragma unroll
    for (int j = 0; j < 4; ++j) { const f32x4 gg = gr[64 * j]; u32x2 w; w.x = cvtpk(v[j].x * rstd * gg.x, v[j].y * rstd * gg.y); w.y = cvtpk(v[j].z * rstd * gg.z, v[j].w * rstd * gg.w); o8[64 * j] = w; }
}

__device__ __forceinline__ int krow(int reg, int h) { return (reg & 3) + 8 * (reg >> 2) + 4 * h; }

struct MaskCmp { int tq[2]; __device__ __forceinline__ bool operator()(int T, int kr, int qb) const { return 16 * (32 * T + kr) + 31 <= tq[qb]; } };
struct MaskWin { int tq[2]; int base; __device__ __forceinline__ bool operator()(int T, int kr, int qb) const { const int kp = base + 32 * T + kr; return kp <= tq[qb] && tq[qb] - kp < 512; } };
struct MaskNone { __device__ __forceinline__ bool operator()(int, int, int) const { return true; } };

template <int HD, int NQB, bool IMP, class Mask>
__device__ __forceinline__ void attn2pass(LAS unsigned char* lds, const bf16* Kg, const bf16* Vg, int T0, int T1, const bf16x8 (&Qf)[NQB][HD / 16],
                                          const Mask& mask, const float (&gate)[NQB], f32x16 (&O)[HD / 32][NQB], LAS unsigned* imp, int tid, int lane) {
    constexpr int KSTR = HD * 2 + 16, VSTR = 80, KBYTES = 32 * KSTR, VBYTES = HD * VSTR;
    constexpr int KCH = 32 * HD * 2 / 16, VCH = KCH;
    constexpr int CPR = HD * 2 / 16;
    LAS unsigned char* KB = lds; LAS unsigned char* VB = lds + 2 * KBYTES;
    const int r32 = lane & 31, h = lane >> 5;
    float mrun[NQB], lrun[NQB];
#pragma unroll
    for (int qb = 0; qb < NQB; ++qb) { mrun[qb] = -1e29f; lrun[qb] = 0.f; }
    u32x4 kreg = (u32x4){0u, 0u, 0u, 0u}, vreg = (u32x4){0u, 0u, 0u, 0u};
    if (T0 < T1 && tid < KCH) kreg = *(const u32x4*)(Kg + (size_t)T0 * 32 * HD + tid * 8);
    for (int T = T0; T < T1; ++T) {
        if (tid < KCH) *(LAS u32x4*)(KB + (T & 1) * KBYTES + (tid / CPR) * KSTR + (tid % CPR) * 16) = kreg;
        __syncthreads();
        if (T + 1 < T1 && tid < KCH) kreg = *(const u32x4*)(Kg + (size_t)(T + 1) * 32 * HD + tid * 8);
        const LAS unsigned char* kb = KB + (T & 1) * KBYTES + r32 * KSTR + h * 16;
        f32x16 S[NQB];
#pragma unroll
        for (int qb = 0; qb < NQB; ++qb) S[qb] = (f32x16){0.f,0.f,0.f,0.f,0.f,0.f,0.f,0.f,0.f,0.f,0.f,0.f,0.f,0.f,0.f,0.f};
#pragma unroll
        for (int s = 0; s < HD / 16; ++s) { const bf16x8 kf = *(const LAS bf16x8*)(kb + s * 32);
#pragma unroll
            for (int qb = 0; qb < NQB; ++qb) S[qb] = __builtin_amdgcn_mfma_f32_32x32x16_bf16(kf, Qf[qb][s], S[qb], 0, 0, 0); }
#pragma unroll
        for (int qb = 0; qb < NQB; ++qb) {
            float tm = -1e30f;
#pragma unroll
            for (int r = 0; r < 16; ++r) { S[qb][r] = mask(T, krow(r, h), qb) ? S[qb][r] : -1e30f; tm = fmaxf(tm, S[qb][r]); }
            const float mn = fmaxf(mrun[qb], tm);
            float sum = 0.f;
#pragma unroll
            for (int r = 0; r < 16; ++r) sum += __builtin_amdgcn_exp2f(S[qb][r] - mn);
            lrun[qb] = lrun[qb] * __builtin_amdgcn_exp2f(mrun[qb] - mn) + sum; mrun[qb] = mn;
        }
    }
    float inv[NQB];
#pragma unroll
    for (int qb = 0; qb < NQB; ++qb) {
        const float mo = __shfl_xor(mrun[qb], 32), lo = __shfl_xor(lrun[qb], 32);
        const float M = fmaxf(mrun[qb], mo);
        const float L = lrun[qb] * __builtin_amdgcn_exp2f(mrun[qb] - M) + lo * __builtin_amdgcn_exp2f(mo - M);
        mrun[qb] = M; inv[qb] = L > 0.f ? 1.0f / L : 0.f;
    }
    __syncthreads();
    if (T0 < T1) { if (tid < KCH) kreg = *(const u32x4*)(Kg + (size_t)T0 * 32 * HD + tid * 8);
                   if (tid >= 512 - VCH) vreg = *(const u32x4*)(Vg + (size_t)T0 * HD * 32 + (tid - (512 - VCH)) * 8); }
    for (int T = T0; T < T1; ++T) {
        if (tid < KCH) *(LAS u32x4*)(KB + (T & 1) * KBYTES + (tid / CPR) * KSTR + (tid % CPR) * 16) = kreg;
        if (tid >= 512 - VCH) { const int vi = tid - (512 - VCH); *(LAS u32x4*)(VB + (T & 1) * VBYTES + (vi >> 2) * VSTR + (vi & 3) * 16) = vreg; }
        __syncthreads();
        if (T + 1 < T1) { if (tid < KCH) kreg = *(const u32x4*)(Kg + (size_t)(T + 1) * 32 * HD + tid * 8);
                          if (tid >= 512 - VCH) vreg = *(const u32x4*)(Vg + (size_t)(T + 1) * HD * 32 + (tid - (512 - VCH)) * 8); }
        const LAS unsigned char* kb = KB + (T & 1) * KBYTES + r32 * KSTR + h * 16;
        const LAS unsigned char* vb = VB + (T & 1) * VBYTES + r32 * VSTR + h * 16;
#pragma unroll
        for (int qb = 0; qb < NQB; ++qb) {
            f32x16 p = (f32x16){0.f,0.f,0.f,0.f,0.f,0.f,0.f,0.f,0.f,0.f,0.f,0.f,0.f,0.f,0.f,0.f};
#pragma unroll
            for (int s = 0; s < HD / 16; ++s) { const bf16x8 kf = *(const LAS bf16x8*)(kb + s * 32);
                p = __builtin_amdgcn_mfma_f32_32x32x16_bf16(kf, Qf[qb][s], p, 0, 0, 0); }
#pragma unroll
            for (int r = 0; r < 16; ++r) { const float sv = mask(T, krow(r, h), qb) ? p[r] : -1e30f; p[r] = __builtin_amdgcn_exp2f(sv - mrun[qb]) * inv[qb]; }
            if constexpr (IMP) {
                const int qrow = (32 * qb + r32) * IMP_STRIDE;
#pragma unroll
                for (int a = 0; a < 4; ++a) {
                    const int jp = 8 * T + 2 * a + h;
                    const float g4 = (p[4 * a] + p[4 * a + 1]) + (p[4 * a + 2] + p[4 * a + 3]), e3 = p[4 * a + 3];
                    if (g4 > 0.f) {
                        atomicAdd((unsigned*)(imp + qrow + jp), (unsigned)(g4 * 16777216.f + 0.5f));
                        if (jp + 1 < 128) atomicAdd((unsigned*)(imp + qrow + jp + 1), (unsigned)(e3 * 16777216.f + 0.5f));
                    }
                }
            }
            const float gt = gate[qb];
            bf16x8 Pf[2];
#pragma unroll
            for (int s2 = 0; s2 < 2; ++s2) { u32x4 w; w.x = cvtpk(p[8 * s2] * gt, p[8 * s2 + 1] * gt); w.y = cvtpk(p[8 * s2 + 2] * gt, p[8 * s2 + 3] * gt);
                w.z = cvtpk(p[8 * s2 + 4] * gt, p[8 * s2 + 5] * gt); w.w = cvtpk(p[8 * s2 + 6] * gt, p[8 * s2 + 7] * gt); Pf[s2] = __builtin_bit_cast(bf16x8, w); }
#pragma unroll
            for (int db = 0; db < HD / 32; ++db)
#pragma unroll
                for (int s2 = 0; s2 < 2; ++s2) { const bf16x8 vf = *(const LAS bf16x8*)(vb + db * 32 * VSTR + s2 * 32);
                    O[db][qb] = __builtin_amdgcn_mfma_f32_32x32x16_bf16(vf, Pf[s2], O[db][qb], 0, 0, 0); }
        }
    }
    __syncthreads();
}

__device__ __forceinline__ void nsa_unit(Frame& F, int b, int g, int c, const bf16* q, const float* gnsa, const bf16* kc, const bf16* vct,
                                         const bf16* kvs, bf16* acat) {
    LAS unsigned char* lds = F.lds;
    int tid = F.tid; asm volatile("" : "+v"(tid));
    const int lane = tid & 63, w = F.wave, r32 = lane & 31, h = lane >> 5;
    LAS unsigned* imp = (LAS unsigned*)(lds + L_IMP);
    LAS int* sel = (LAS int*)(lds + L_SEL);
    LAS int* selcnt = (LAS int*)(lds + L_SELCNT);
    LAS unsigned char* yt = lds + L_YT;
    const int bg = b * 2 + g, head = 8 * g + w;
    const size_t rowbase = (size_t)b * SEQ + 64 * c;
    for (int i = tid; i < 64 * IMP_STRIDE; i += 512) imp[i] = 0u;
    bf16x8 Qf[2][4]; float g0[2], g2[2]; int tq[2];
#pragma unroll
    for (int qb = 0; qb < 2; ++qb) {
        const size_t row = rowbase + 32 * qb + r32; tq[qb] = 64 * c + 32 * qb + r32;
#pragma unroll
        for (int s = 0; s < 4; ++s) Qf[qb][s] = *(const bf16x8*)(q + row * 1024 + head * 64 + 16 * s + 8 * h);
        g0[qb] = gnsa[row * 48 + head * 3 + 0]; g2[qb] = gnsa[row * 48 + head * 3 + 2];
    }
    f32x16 O[2][2];
#pragma unroll
    for (int db = 0; db < 2; ++db)
#pragma unroll
        for (int qb = 0; qb < 2; ++qb) O[db][qb] = (f32x16){0.f,0.f,0.f,0.f,0.f,0.f,0.f,0.f,0.f,0.f,0.f,0.f,0.f,0.f,0.f,0.f};
    __syncthreads();
#ifndef NO_CMP
    { MaskCmp mk; mk.tq[0] = tq[0]; mk.tq[1] = tq[1];
      const int NT = (4 * c + 2) / 32 + 1;
      attn2pass<64, 2, true>(lds, kc + (size_t)bg * 512 * 64, vct + (size_t)bg * 16 * 2048, 0, NT, Qf, mk, g0, O, imp, tid, lane);
#if (P3REP & 1)
      { float z0 = 0.f; asm volatile("" : "+v"(z0)); const float gz[2] = {z0, z0};
        attn2pass<64, 2, true>(lds, kc + (size_t)bg * 512 * 64, vct + (size_t)bg * 16 * 2048, 0, NT, Qf, mk, gz, O, imp, tid, lane); }
#endif
    }
#endif
#ifndef NO_TOPK
    for (int rp_ = 0; rp_ < ((P3REP & 2) ? 2 : 1); ++rp_)
    for (int qi = 0; qi < 8; ++qi) {
        const int ql = 8 * w + qi;
        unsigned long long blo, bhi;
        if (c < 16) { blo = (2ull << c) - 1ull; bhi = 0ull; }
        else {
            const int hi = c - 2;
            const int j0 = 1 + lane, j1 = 65 + lane;
            const bool ok0 = j0 <= hi, ok1 = j1 <= hi;
            const unsigned v0 = ok0 ? imp[ql * IMP_STRIDE + j0] : 0u, v1 = ok1 ? imp[ql * IMP_STRIDE + j1] : 0u;
            unsigned T = 0u;
            for (int bit = 30; bit >= 0; --bit) { const unsigned cand = T | (1u << bit);
                const int cnt = __popcll(__ballot(v0 >= cand)) + __popcll(__ballot(v1 >= cand));
                if (cnt >= 13) T = cand; }
            const unsigned long long gt0 = __ballot(ok0 && v0 > T), gt1 = __ballot(ok1 && v1 > T);
            const unsigned long long eq0 = __ballot(ok0 && v0 == T), eq1 = __ballot(ok1 && v1 == T);
            const int need = 13 - __popcll(gt0) - __popcll(gt1);
            const unsigned long long lt = (1ull << lane) - 1ull;
            const bool t0 = ok0 && v0 == T && __popcll(eq0 & lt) < need, t1 = ok1 && v1 == T && (__popcll(eq0) + __popcll(eq1 & lt)) < need;
            const unsigned long long m0 = gt0 | __ballot(t0), m1 = gt1 | __ballot(t1);
            blo = (m0 << 1) | 1ull; bhi = (m1 << 1) | (m0 >> 63);
            if (c - 1 < 64) blo |= 1ull << (c - 1); else bhi |= 1ull << (c - 65);
            if (c < 64) blo |= 1ull << c; else bhi |= 1ull << (c - 64);
        }
        if (lane == 0) { LAS unsigned long long* sb = (LAS unsigned long long*)(lds + L_SEL) + ql * 2; sb[0] = blo; sb[1] = bhi; }
    }
#endif
#ifndef NO_WIN
    { MaskWin mk; mk.tq[0] = tq[0]; mk.tq[1] = tq[1]; mk.base = 64 * c - 512;
      const int T0 = (16 - 2 * c) > 0 ? (16 - 2 * c) : 0;
      const bf16* kw = kvs + 4 * KVSLAB + ((size_t)bg * 8192 + 64 * c - 512) * 64;
      const bf16* vw = kvs + 5 * KVSLAB + ((size_t)bg * 256 + 2 * c - 16) * 2048;
      attn2pass<64, 2, false>(lds, kw, vw, T0, 18, Qf, mk, g2, O, imp, tid, lane);
#if (P3REP & 4)
      { float z0 = 0.f; asm volatile("" : "+v"(z0)); const float gz[2] = {z0, z0};
        attn2pass<64, 2, false>(lds, kw, vw, T0, 18, Qf, mk, gz, O, imp, tid, lane); }
#endif
    }
#endif
#pragma unroll
    for (int db = 0; db < 2; ++db)
#pragma unroll
        for (int qb = 0; qb < 2; ++qb)
#pragma unroll
            for (int a = 0; a < 4; ++a) {
                u32x2 wv; wv.x = cvtpk(O[db][qb][4 * a], O[db][qb][4 * a + 1]); wv.y = cvtpk(O[db][qb][4 * a + 2], O[db][qb][4 * a + 3]);
                *(LAS u32x2*)(yt + (32 * qb + r32) * YT_STRIDE + (w * 64 + 32 * db + 8 * a + 4 * h) * 2) = wv;
            }
    __syncthreads();
#ifndef NO_SEL
    {
        int tid_o = tid; asm volatile("" : "+v"(tid_o));
        const int lane_o = tid_o & 63, n16 = lane_o & 15, kq = lane_o >> 4, qh = n16 >> 3;
        constexpr int SROW = 144, SKB = 64 * SROW, SBUF = 2 * SKB;
        const bf16* ksb = kvs + 2 * KVSLAB + (size_t)bg * 8192 * 64;
        const bf16* vsb = kvs + 3 * KVSLAB + (size_t)bg * 128 * 4096;
        for (int rp_ = 0; rp_ < ((P3REP & 8) ? 2 : 1); ++rp_) {
        float scm = (rp_ == 0) ? 1.f : 0.f; asm volatile("" : "+v"(scm));
        bf16x8 Qp[4][2]; float mrun[4], lrun[4]; f32x4 Os[4][4];
#pragma unroll
        for (int pp = 0; pp < 4; ++pp) {
            const size_t row = rowbase + 8 * w + 2 * pp + qh;
#pragma unroll
            for (int s = 0; s < 2; ++s) Qp[pp][s] = *(const bf16x8*)(q + row * 1024 + (8 * g + (n16 & 7)) * 64 + 32 * s + 8 * kq);
            mrun[pp] = -1e29f; lrun[pp] = 0.f;
#pragma unroll
            for (int dt = 0; dt < 4; ++dt) Os[pp][dt] = (f32x4){0.f, 0.f, 0.f, 0.f};
        }
        unsigned long long mylo = 0ull, myhi = 0ull;
        if (lane_o < 8) { const LAS unsigned long long* sb = (const LAS unsigned long long*)(lds + L_SEL) + (8 * w + lane_o) * 2; mylo = sb[0]; myhi = sb[1]; }
        const int srow = tid_o >> 3, sch = tid_o & 7;
        u32x4 kreg = *(const u32x4*)(ksb + srow * 64 + sch * 8), vreg = *(const u32x4*)(vsb + srow * 64 + sch * 8);
        for (int j = 0; j <= c; ++j) {
            LAS unsigned char* kb = lds + (j & 1) * SBUF; LAS unsigned char* vb = kb + SKB;
            *(LAS u32x4*)(kb + srow * SROW + sch * 16) = kreg; *(LAS u32x4*)(vb + srow * SROW + sch * 16) = vreg;
            __syncthreads();
            if (j < c) { kreg = *(const u32x4*)(ksb + (size_t)(j + 1) * 4096 + srow * 64 + sch * 8); vreg = *(const u32x4*)(vsb + (size_t)(j + 1) * 4096 + srow * 64 + sch * 8); }
            const unsigned act = (unsigned)__ballot((((j < 64 ? mylo : myhi) >> (j & 63)) & 1ull) != 0ull) & 0xffu;
            const LAS unsigned char* kfp = kb + n16 * SROW + kq * 16; const LAS unsigned char* vfp = vb + n16 * SROW + kq * 16;
#pragma unroll
            for (int pp = 0; pp < 4; ++pp) {
                if (((act >> (2 * pp)) & 3u) == 0u) continue;
                const bool colsel = ((act >> (2 * pp + qh)) & 1u) != 0u;
                const int tcol = 64 * c + 8 * w + 2 * pp + qh;
                f32x4 S[4];
#pragma unroll
                for (int kt = 0; kt < 4; ++kt) {
                    S[kt] = __builtin_amdgcn_mfma_f32_16x16x32_bf16(*(const LAS bf16x8*)(kfp + kt * 16 * SROW), Qp[pp][0], (f32x4){0.f, 0.f, 0.f, 0.f}, 0, 0, 0);
                    S[kt] = __builtin_amdgcn_mfma_f32_16x16x32_bf16(*(const LAS bf16x8*)(kfp + kt * 16 * SROW + 64), Qp[pp][1], S[kt], 0, 0, 0); }
                const int lim = colsel ? (j < c ? 64 : tcol - 64 * c - 4 * kq) : -1;
                float bm = -1e30f;
#pragma unroll
                for (int kt = 0; kt < 4; ++kt)
#pragma unroll
                    for (int r = 0; r < 4; ++r) { S[kt][r] = (16 * kt + r <= lim) ? S[kt][r] : -1e30f; bm = fmaxf(bm, S[kt][r]); }
                bm = fmaxf(bm, __shfl_xor(bm, 16)); bm = fmaxf(bm, __shfl_xor(bm, 32));
                const float mn = fmaxf(mrun[pp], bm), alpha = __builtin_amdgcn_exp2f(mrun[pp] - mn);
                float sum = 0.f;
#pragma unroll
                for (int kt = 0; kt < 4; ++kt)
#pragma unroll
                    for (int r = 0; r < 4; ++r) { const float p = __builtin_amdgcn_exp2f(S[kt][r] - mn); S[kt][r] = p; sum += p; }
                lrun[pp] = lrun[pp] * alpha + sum; mrun[pp] = mn;
                bf16x8 Pb[2];
#pragma unroll
                for (int s = 0; s < 2; ++s) { u32x4 wv; wv.x = cvtpk(S[2 * s][0], S[2 * s][1]); wv.y = cvtpk(S[2 * s][2], S[2 * s][3]);
                    wv.z = cvtpk(S[2 * s + 1][0], S[2 * s + 1][1]); wv.w = cvtpk(S[2 * s + 1][2], S[2 * s + 1][3]); Pb[s] = __builtin_bit_cast(bf16x8, wv); }
#pragma unroll
                for (int dt = 0; dt < 4; ++dt) { Os[pp][dt] = Os[pp][dt] * alpha;
                    Os[pp][dt] = __builtin_amdgcn_mfma_f32_16x16x32_bf16(*(const LAS bf16x8*)(vfp + dt * 16 * SROW), Pb[0], Os[pp][dt], 0, 0, 0);
                    Os[pp][dt] = __builtin_amdgcn_mfma_f32_16x16x32_bf16(*(const LAS bf16x8*)(vfp + dt * 16 * SROW + 64), Pb[1], Os[pp][dt], 0, 0, 0); }
            }
        }
#pragma unroll
        for (int pp = 0; pp < 4; ++pp) {
            float L = lrun[pp]; L += __shfl_xor(L, 16); L += __shfl_xor(L, 32);
            const int ql = 8 * w + 2 * pp + qh;
            const float sc = (L > 0.f ? 1.0f / L : 0.f) * gnsa[(rowbase + ql) * 48 + (8 * g + (n16 & 7)) * 3 + 1] * scm;
#pragma unroll
            for (int dt = 0; dt < 4; ++dt) {
                LAS u32x2* yp = (LAS u32x2*)(yt + ql * YT_STRIDE + ((n16 & 7) * 64 + 16 * dt + 4 * kq) * 2);
                const u32x2 old = *yp; u32x2 nw;
                nw.x = cvtpk(bflo(old.x) + Os[pp][dt][0] * sc, bfhi(old.x) + Os[pp][dt][1] * sc);
                nw.y = cvtpk(bflo(old.y) + Os[pp][dt][2] * sc, bfhi(old.y) + Os[pp][dt][3] * sc);
                *yp = nw;
            }
        }
        __syncthreads();
        }
    }
#endif
    __syncthreads();
#pragma unroll
    for (int i = 0; i < 8; ++i) { const int idx = tid + 512 * i, rr = idx >> 6, ch = idx & 63;
        const u32x4 v = *(const LAS u32x4*)(yt + rr * YT_STRIDE + ch * 16);
        *(u32x4*)(acat + (rowbase + rr) * 2048 + 512 + g * 512 + ch * 8) = v; }
    __syncthreads();
}

__device__ __forceinline__ void mem_unit(Frame& F, int b, int head, int chunk, const bf16* qx, const bf16* mk, const bf16* mvt, bf16* acat) {
    int lane = F.lane; asm volatile("" : "+v"(lane));
    const int r32 = lane & 31, h = lane >> 5;
    const size_t row = (size_t)b * SEQ + 256 * chunk + 32 * F.wave + r32;
    bf16x8 Qf[1][8];
#pragma unroll
    for (int s = 0; s < 8; ++s) Qf[0][s] = *(const bf16x8*)(qx + row * 512 + head * 128 + 16 * s + 8 * h);
    f32x16 O[4][1];
#pragma unroll
    for (int db = 0; db < 4; ++db) O[db][0] = (f32x16){0.f,0.f,0.f,0.f,0.f,0.f,0.f,0.f,0.f,0.f,0.f,0.f,0.f,0.f,0.f,0.f};
    const float gate[1] = {1.0f}; MaskNone mk0;
    attn2pass<128, 1, false>(F.lds, mk + (size_t)(b * 4 + head) * 256 * 128, mvt + (size_t)(b * 4 + head) * 8 * 4096, 0, 8, Qf, mk0, gate, O, (LAS unsigned*)nullptr, F.tid, lane);
#pragma unroll
    for (int db = 0; db < 4; ++db)
#pragma unroll
        for (int a = 0; a < 4; ++a) {
            u32x2 wv; wv.x = cvtpk(O[db][0][4 * a], O[db][0][4 * a + 1]); wv.y = cvtpk(O[db][0][4 * a + 2], O[db][0][4 * a + 3]);
            *(u32x2*)(acat + row * 2048 + 1536 + head * 128 + 32 * db + 8 * a + 4 * h) = wv;
        }
}

constexpr int NPHASE = 11;
__global__ void __launch_bounds__(512, 2) mk_fwd(Args args) {
    extern __shared__ __attribute__((aligned(16))) unsigned char lds_raw[];
    Frame F;
    F.lds = (LAS unsigned char*)lds_raw;
    F.tid = threadIdx.x; F.lane = F.tid & 63; F.wave = __builtin_amdgcn_readfirstlane(F.tid >> 6);
    F.G = gridDim.x; F.bx = blockIdx.x; F.vcu = (F.G % 8 == 0) ? (F.bx % 8) * (F.G / 8) + F.bx / 8 : F.bx;
    unsigned char* ws = args.ws;
    gu32* ctl = (gu32*)(ws + WS_CTL);
    volatile LAS unsigned* MISC = (volatile LAS unsigned*)(F.lds + MISC_OFF);
    for (int u = F.tid; u < (LDS_BYTES - LDSCTL_OFF) / 4; u += 512) ((LAS unsigned*)(F.lds + LDSCTL_OFF))[u] = 0u;
    __syncthreads();
#if MK_LAUNCHES == 1
    XcdBarrier bar = xcd_barrier_post((unsigned*)(ctl + CW_BAR), MISC + 8);
#define GRID_BAR() xcd_barrier(bar)
#else
#define GRID_BAR() do {} while (0)
#endif
    const int lo = args.ph_lo, hi = args.ph_hi;
#ifndef PH_MASK
#define PH_MASK 0x7ff
#endif
#define IN(k) ((((PH_MASK) >> (k)) & 1) && lo <= (k) && (k) < hi)
#ifndef REPEAT_MASK
#define REPEAT_MASK 0
#endif
#define NREP(k) ((((REPEAT_MASK) >> (k)) & 1) ? 2 : 1)
#define SEAM(k) do { if (IN(k) && IN((k) + 1)) GRID_BAR(); } while (0)
    const float* x = args.in[0]; const float* mem = args.in[1]; const int* positions = (const int*)args.in[2];
    const float* pre_mix_g = args.in[3]; const float* w_in = args.in[4]; const float* pool_w = args.in[5]; const float* pool_scale = args.in[6];
    const float* cmp_pe = args.in[7]; const float* cmp_w1 = args.in[8]; const float* cmp_w2 = args.in[9]; const float* mem_norm_g = args.in[10];
    const float* w_mem_kv = args.in[11]; const float* w_br_pool = args.in[12]; const float* w_br_nsa = args.in[13]; const float* w_br_xa = args.in[14];
    const float* w_out = args.in[15]; const float* post_mix_g = args.in[16]; const float* pre_ffn_g = args.in[17]; const float* w_up = args.in[18];
    const float* conv_w = args.in[19]; const float* conv_b = args.in[20]; const float* w_down = args.in[21]; const float* post_ffn_g = args.in[22];
    float* out = args.out;
    bf16* q_buf = (bf16*)out; bf16* qx_buf = (bf16*)((char*)out + 32 * MiB); bf16* upool = (bf16*)((char*)out + 48 * MiB);
    float* rope = (float*)(ws + WS_ROPE); float* bias1 = (float*)(ws + WS_BIAS1); float* b1part = (float*)(ws + WS_B1PART);
    bf16* wc2t = (bf16*)(ws + WS_WC2T); bf16* kc = (bf16*)(ws + WS_KC); bf16* vct = (bf16*)(ws + WS_VCT);
    bf16* memn = (bf16*)(ws + WS_MEMN); bf16* memk = (bf16*)(ws + WS_MEMK); bf16* memvt = (bf16*)(ws + WS_MEMVT);
    bf16* hid = (bf16*)(ws + WS_HID); float* gnsa = (float*)(ws + WS_GNSA);
    bf16* wcat = (bf16*)(ws + WS_WCAT); bf16* wout_t = (bf16*)(ws + WS_WOUT); bf16* wup_t = (bf16*)(ws + WS_WUP); bf16* wdown_t = (bf16*)(ws + WS_WDOWN);
    bf16* wmem_t = (bf16*)(ws + WS_WMEM); bf16* wc1_t = (bf16*)(ws + WS_WC1); bf16* win_t = (bf16*)(ws + WS_WIN);
    bf16* kvs = (bf16*)(ws + WS_KV); bf16* ybuf = (bf16*)(ws + WS_Y); float* fbuf = (float*)(ws + WS_F);
    bf16* acat = (bf16*)(ws + WS_ACAT); bf16* hbuf = (bf16*)(ws + WS_ACAT); bf16* gbr = (bf16*)(ws + WS_GBR); bf16* a2 = (bf16*)(ws + WS_A2); bf16* halo = (bf16*)(ws + WS_HALO);
    const int gw = F.vcu * 8 + F.wave, NGW = F.G * 8;
    const int gt = F.vcu * 512 + F.tid, NGT = F.G * 512;

    for (int rep_ = 0; rep_ < NREP(0); ++rep_) { if (rep_) GRID_BAR();
    if (IN(0)) {
        LAS float* scr = (LAS float*)(F.lds + F.wave * 16384);
        constexpr int I_IN = 16 * 192, I_UP = 16 * 176, I_DN = 44 * 32, I_NSA = 16 * 32, I_XA = 8 * 32, I_OUT = 16 * 32, I_MEM = 16 * 32, I_C1 = 32 * 8, I_C2 = 4 * 2;
        constexpr int NITEMS = I_IN + I_UP + I_DN + I_NSA + I_XA + I_OUT + I_MEM + 2 * I_C1 + 2 * I_C2;
        for (int it = gw; it < NITEMS; it += NGW) {
            int r = it;
            if (r < I_IN) { transpose_item(w_in, DIN, win_t, 1024, 0, scr, 192, r, F.lane, MapIn()); continue; } r -= I_IN;
            if (r < I_UP) { transpose_item(w_up, DFF2, wup_t, 1024, 0, scr, 176, r, F.lane, MapUp()); continue; } r -= I_UP;
            if (r < I_DN) { transpose_item(w_down, 1024, wdown_t, DFF, 0, scr, 32, r, F.lane, MapId()); continue; } r -= I_DN;
            if (r < I_NSA) { transpose_item(w_br_nsa, 1024, wcat, 2048, 512, scr, 32, r, F.lane, MapId()); continue; } r -= I_NSA;
            if (r < I_XA) { transpose_item(w_br_xa, 1024, wcat, 2048, 1536, scr, 32, r, F.lane, MapId()); continue; } r -= I_XA;
            if (r < I_OUT) { transpose_item(w_out, 1024, wout_t, 1024, 0, scr, 32, r, F.lane, MapId()); continue; } r -= I_OUT;
            if (r < I_MEM) { transpose_item(w_mem_kv, 1024, wmem_t, 1024, 0, scr, 32, r, F.lane, MapId()); continue; } r -= I_MEM;
            if (r < 2 * I_C1) { const int z = r / I_C1; transpose_item(cmp_w1 + (size_t)z * 2048 * 256, 256, wc1_t + (size_t)z * 256 * 2048, 2048, 0, scr, 8, r % I_C1, F.lane, MapId()); continue; } r -= 2 * I_C1;
            { const int z = r / I_C2; transpose_item(cmp_w2 + (size_t)z * 256 * 64, 64, wc2t + (size_t)z * 64 * 256, 256, 0, scr, 2, r % I_C2, F.lane, MapId()); }
        }
        for (int m = gw; m < MTOK + 512; m += NGW) {
            if (m < MTOK) rms_row_to_bf16(x + (size_t)m * DM, pre_mix_g, hbuf + (size_t)m * DM, F.lane);
            else rms_row_to_bf16(mem + (size_t)(m - MTOK) * DM, mem_norm_g, memn + (size_t)(m - MTOK) * DM, F.lane);
        }
        for (int i = gt; i < MTOK * 8; i += NGT) { const int row = i >> 3, k = i & 7; const float ang = (float)positions[row] * args.invf[k];
            rope[(size_t)row * 16 + k] = cosf(ang); rope[(size_t)row * 16 + 8 + k] = sinf(ang); }
        for (int tsk = gw; tsk < 2 * 16 * 4; tsk += NGW) { const int z = tsk >> 6, kcn = (tsk >> 2) & 15, nb = tsk & 3, n = nb * 64 + F.lane;
            const float* pe = cmp_pe + (size_t)z * 2048 + kcn * 128; const float* w1 = cmp_w1 + ((size_t)z * 2048 + kcn * 128) * 256 + n; float s = 0.f;
#pragma unroll 8
            for (int k = 0; k < 128; ++k) s += pe[k] * w1[(size_t)k * 256];
            b1part[(z * 16 + kcn) * 256 + n] = s; }
        for (int tsk = gw; tsk < 64 * 16; tsk += NGW) { const int k8 = tsk >> 4, nb = tsk & 15, n = nb * 64 + F.lane, gi = k8 >> 4, cc0 = (k8 & 15) * 8;
            float accw[8];
#pragma unroll
            for (int j = 0; j < 8; ++j) accw[j] = 0.f;
            for (int d = 0; d < 128; ++d) { const float wv = pool_scale[gi * 128 + d] * w_br_pool[(size_t)(gi * 128 + d) * 1024 + n];
#pragma unroll
                for (int j = 0; j < 8; ++j) accw[j] += pool_w[((size_t)gi * 128 + cc0 + j) * 128 + d] * wv; }
            u32x4 o; o.x = cvtpk(accw[0], accw[1]); o.y = cvtpk(accw[2], accw[3]); o.z = cvtpk(accw[4], accw[5]); o.w = cvtpk(accw[6], accw[7]);
            *(u32x4*)(wcat + (size_t)n * 2048 + gi * 128 + cc0) = o; }
    }
    }
    SEAM(0);

    for (int rep_ = 0; rep_ < NREP(1); ++rep_) { if (rep_) GRID_BAR();
    if (IN(1)) {
        if (F.bx == 0) { const int z = F.tid >> 8, n = F.tid & 255; float s = 0.f;
#pragma unroll
            for (int k = 0; k < 16; ++k) s += b1part[(z * 16 + k) * 256 + n];
            bias1[z * 256 + n] = s; }
        pg8::Gemm g{hbuf, win_t, 1024, 1024}; pg8::SchedGrid S{64, 24, F.G, F.bx, 16};
        pg8::EpiIn E{upool, q_buf, qx_buf, gbr, gnsa, kvs, rope};
        pg8::gemm_phase<pg8::EpiIn, pg8::SchedGrid, true>(F.lds, g, S, E);
    }
    }
    SEAM(1);

    for (int rep_ = 0; rep_ < NREP(2); ++rep_) { if (rep_) GRID_BAR();
    if (IN(2)) {
        if (F.bx < 16) {
            pg8::Gemm g{kvs, wc1_t, 1024, 2048}; pg8::SchedCmp S{16, F.bx};
            pg8::EpiCmp E{hid, bias1};
            pg8::gemm_phase<pg8::EpiCmp, pg8::SchedCmp, true>(F.lds, g, S, E);
            VM_WAIT(); __syncthreads();
            const int z = F.bx >> 3, R0 = F.bx * 256 + 32 * F.wave, r32 = F.lane & 31, h = F.lane >> 5;
            f32x16 C[2]; C[0] = (f32x16){0.f,0.f,0.f,0.f,0.f,0.f,0.f,0.f,0.f,0.f,0.f,0.f,0.f,0.f,0.f,0.f}; C[1] = C[0];
#pragma unroll 4
            for (int s = 0; s < 16; ++s) {
                const bf16x8 af = *(const bf16x8*)(hid + (size_t)(R0 + r32) * 256 + 16 * s + 8 * h);
#pragma unroll
                for (int nb = 0; nb < 2; ++nb) { const bf16x8 bfr = *(const bf16x8*)(wc2t + ((size_t)z * 64 + nb * 32 + r32) * 256 + 16 * s + 8 * h);
                    C[nb] = __builtin_amdgcn_mfma_f32_32x32x16_bf16(af, bfr, C[nb], 0, 0, 0); }
            }
#pragma unroll
            for (int nb = 0; nb < 2; ++nb)
#pragma unroll
                for (int r = 0; r < 16; ++r) {
                    const int R = R0 + krow(r, h), bgi = (R >> 9) & 3, i = R & 511, n = nb * 32 + r32;
                    if (z == 0) kc[((size_t)bgi * 512 + i) * 64 + n] = f2bf(C[nb][r]);
                    else { const int kk = i & 31, pos = (kk & 16) | (kk & 3) | (((kk >> 3) & 1) << 2) | (((kk >> 2) & 1) << 3);
                           vct[(((size_t)bgi * 16 + (i >> 5)) * 64 + n) * 32 + pos] = f2bf(C[nb][r]); }
                }
        } else if (F.bx < 24) {
            pg8::Gemm g{memn, wmem_t, 1024, 1024}; pg8::SchedGrid S{2, 4, 8, F.bx - 16, 16};
            pg8::EpiMemKV E{memk, memvt};
            pg8::gemm_phase<pg8::EpiMemKV, pg8::SchedGrid, true>(F.lds, g, S, E);
        } else {
            const int nthr = (F.G - 24) * 512;
            for (int i = (F.bx - 24) * 512 + F.tid; i < MTOK * 64; i += nthr) {
                const int row = i >> 6, o = i & 63, t = row & 8191, wsz = 2 << (o >> 4);
                const int cnt = (t + 1) < wsz ? (t + 1) : wsz;
                float s[8];
#pragma unroll
                for (int e = 0; e < 8; ++e) s[e] = 0.f;
                u32x4 cur = (u32x4){0u, 0u, 0u, 0u};
                for (int k = 0; k < cnt; ++k) { const u32x4 v = *(const u32x4*)(upool + (size_t)(row - k) * 512 + o * 8); if (k == 0) cur = v;
                    s[0] += bflo(v.x); s[1] += bfhi(v.x); s[2] += bflo(v.y); s[3] += bfhi(v.y); s[4] += bflo(v.z); s[5] += bfhi(v.z); s[6] += bflo(v.w); s[7] += bfhi(v.w); }
                const float ic = 1.0f / (float)cnt;
                u32x4 w; w.x = cvtpk(s[0] * ic - bflo(cur.x), s[1] * ic - bfhi(cur.x)); w.y = cvtpk(s[2] * ic - bflo(cur.y), s[3] * ic - bfhi(cur.y));
                w.z = cvtpk(s[4] * ic - bflo(cur.z), s[5] * ic - bfhi(cur.z)); w.w = cvtpk(s[6] * ic - bflo(cur.w), s[7] * ic - bfhi(cur.w));
                *(u32x4*)(acat + (size_t)row * 2048 + o * 8) = w;
            }
        }
    }
    }
    SEAM(2);

    for (int rep_ = 0; rep_ < NREP(3); ++rep_) { if (rep_) GRID_BAR();
    if (IN(3)) {
        for (int v = F.vcu; v < 256; v += F.G) {
            const int bg = v >> 6, pi = v & 63;
#ifndef NO_NSA
            for (int uu = 0; uu < 2; ++uu) nsa_unit(F, bg >> 1, bg & 1, uu ? 127 - pi : pi, q_buf, gnsa, kc, vct, kvs, acat);
#endif
#ifndef NO_MEM
            for (int rp_ = 0; rp_ < ((P3REP & 16) ? 2 : 1); ++rp_) mem_unit(F, v >> 7, (v >> 5) & 3, v & 31, qx_buf, memk, memvt, acat);
#endif
        }
    }
    }
    SEAM(3);

    for (int rep_ = 0; rep_ < NREP(4); ++rep_) { if (rep_) GRID_BAR();
    if (IN(4)) {
        pg8::Gemm g{acat, wcat, 2048, 2048}; pg8::SchedCat S{F.G, F.bx};
        pg8::EpiGate E{gbr, out, ybuf};
        pg8::gemm_phase<pg8::EpiGate, pg8::SchedCat, true>(F.lds, g, S, E);
    }
    }
    SEAM(4);

    for (int rep_ = 0; rep_ < NREP(5); ++rep_) { if (rep_) GRID_BAR();
    if (IN(5)) {
        pg8::Gemm g{ybuf, wout_t, 1024, 1024}; pg8::SchedGrid S{64, 4, F.G, F.bx, 16};
        pg8::EpiF32 E{out, 1024};
        pg8::gemm_phase<pg8::EpiF32, pg8::SchedGrid, true>(F.lds, g, S, E);
    }
    }
    SEAM(5);

    for (int rep_ = 0; rep_ < NREP(6); ++rep_) { if (rep_) GRID_BAR();
    if (IN(6)) {
        for (int m = gw; m < MTOK; m += NGW) {
            f32x4* yr = (f32x4*)(out + (size_t)m * DM) + F.lane; const f32x4* xr = (const f32x4*)(x + (size_t)m * DM) + F.lane;
            const f32x4* g1 = (const f32x4*)post_mix_g + F.lane; const f32x4* g2 = (const f32x4*)pre_ffn_g + F.lane;
            f32x4 v[4]; float s = 0.f;
#pragma unroll
            for (int j = 0; j < 4; ++j) { v[j] = yr[64 * j]; s += (v[j].x * v[j].x + v[j].y * v[j].y) + (v[j].z * v[j].z + v[j].w * v[j].w); }
            const float rstd = 1.0f / sqrtf(wave_sum(s) * (1.f / DM) + EPS); float s2 = 0.f;
#pragma unroll
            for (int j = 0; j < 4; ++j) { v[j] = xr[64 * j] + v[j] * rstd * g1[64 * j]; yr[64 * j] = v[j]; s2 += (v[j].x * v[j].x + v[j].y * v[j].y) + (v[j].z * v[j].z + v[j].w * v[j].w); }
            const float rstd2 = 1.0f / sqrtf(wave_sum(s2) * (1.f / DM) + EPS);
            u32x2* o8 = (u32x2*)(hbuf + (size_t)m * DM) + F.lane;
#pragma unroll
            for (int j = 0; j < 4; ++j) { const f32x4 gg = g2[64 * j]; u32x2 w; w.x = cvtpk(v[j].x * rstd2 * gg.x, v[j].y * rstd2 * gg.y); w.y = cvtpk(v[j].z * rstd2 * gg.z, v[j].w * rstd2 * gg.w); o8[64 * j] = w; }
        }
    }
    }
    SEAM(6);

    for (int rep_ = 0; rep_ < NREP(7); ++rep_) { if (rep_) GRID_BAR();
    if (IN(7)) {
        pg8::Gemm g{hbuf, wup_t, 1024, 1024}; pg8::SchedGrid S{64, 22, F.G, F.bx, 16};
        pg8::EpiConv E{a2, halo, conv_w, conv_b};
        pg8::gemm_phase<pg8::EpiConv, pg8::SchedGrid, true>(F.lds, g, S, E);
    }
    }
    SEAM(7);

    for (int rep_ = 0; rep_ < NREP(8); ++rep_) { if (rep_) GRID_BAR();
    if (IN(8)) {
        for (int i = gt; i < 256 * 2 * (DFF / 4); i += NGT) {
            const int c4 = i % (DFF / 4), rr = (i / (DFF / 4)) & 1, k = i / (2 * (DFF / 4)), ch = c4 * 4;
            const int gcol = 256 * (ch >> 7) + (ch & 127);
            const bool first = (k & 127) == 0;
            float cv[2][4];
#pragma unroll
            for (int bj = 0; bj < 2; ++bj) {
                const int ci = bj * DFF + ch; const bf16* hp = halo + (size_t)k * 4 * DFF2 + gcol + bj * 128;
                const f32x4 w0 = *(const f32x4*)(conv_w + ci), w1 = *(const f32x4*)(conv_w + DFF2 + ci), w2 = *(const f32x4*)(conv_w + 2 * DFF2 + ci), bb = *(const f32x4*)(conv_b + ci);
                u32x2 um2 = *(const u32x2*)(hp + (size_t)(rr + 0) * DFF2), um1 = *(const u32x2*)(hp + (size_t)(rr + 1) * DFF2), u0 = *(const u32x2*)(hp + (size_t)(rr + 2) * DFF2);
                if (first && rr == 0) { um2 = (u32x2){0u, 0u}; um1 = (u32x2){0u, 0u}; }
                if (first && rr == 1) { um2 = (u32x2){0u, 0u}; }
                cv[bj][0] = bb[0] + w0[0] * bflo(um2.x) + w1[0] * bflo(um1.x) + w2[0] * bflo(u0.x);
                cv[bj][1] = bb[1] + w0[1] * bfhi(um2.x) + w1[1] * bfhi(um1.x) + w2[1] * bfhi(u0.x);
                cv[bj][2] = bb[2] + w0[2] * bflo(um2.y) + w1[2] * bflo(um1.y) + w2[2] * bflo(u0.y);
                cv[bj][3] = bb[3] + w0[3] * bfhi(um2.y) + w1[3] * bfhi(um1.y) + w2[3] * bfhi(u0.y);
            }
            u32x2 w; w.x = cvtpk(gelu_tanh(cv[0][0]) * cv[1][0], gelu_tanh(cv[0][1]) * cv[1][1]); w.y = cvtpk(gelu_tanh(cv[0][2]) * cv[1][2], gelu_tanh(cv[0][3]) * cv[1][3]);
            *(u32x2*)(a2 + (size_t)(64 * k + rr) * DFF + ch) = w;
        }
    }
    }
    SEAM(8);

    for (int rep_ = 0; rep_ < NREP(9); ++rep_) { if (rep_) GRID_BAR();
    if (IN(9)) {
        pg8::Gemm g{a2, wdown_t, DFF, DFF}; pg8::SchedGrid S{64, 4, F.G, F.bx, 44};
        pg8::EpiF32 E{fbuf, 1024};
        pg8::gemm_phase<pg8::EpiF32, pg8::SchedGrid, true>(F.lds, g, S, E);
    }
    }
    SEAM(9);

    for (int rep_ = 0; rep_ < NREP(10); ++rep_) { if (rep_) GRID_BAR();
    if (IN(10)) {
        for (int m = gw; m < MTOK; m += NGW) {
            f32x4* orow = (f32x4*)(out + (size_t)m * DM) + F.lane; const f32x4* fr_ = (const f32x4*)(fbuf + (size_t)m * DM) + F.lane;
            const f32x4* g4 = (const f32x4*)post_ffn_g + F.lane;
            f32x4 v[4]; float s = 0.f;
#pragma unroll
            for (int j = 0; j < 4; ++j) { v[j] = fr_[64 * j]; s += (v[j].x * v[j].x + v[j].y * v[j].y) + (v[j].z * v[j].z + v[j].w * v[j].w); }
            const float rstd = 1.0f / sqrtf(wave_sum(s) * (1.f / DM) + EPS);
#pragma unroll
            for (int j = 0; j < 4; ++j) orow[64 * j] = orow[64 * j] + v[j] * rstd * g4[64 * j];
        }
    }
    }
#undef IN
#undef SEAM
}

extern "C" void kernel_launch(void* const* d_in, const int* in_sizes, int n_in, void* d_out, int out_size, void* d_ws, size_t ws_size, hipStream_t stream) {
    static int grid = 0;
    if (grid == 0) {
        if (n_in != 23 || in_sizes[0] != MTOK * DM || out_size != MTOK * DM || ws_size < WS_END) {
            fprintf(stderr, "kernel_launch: unexpected problem shape (n_in %d, in0 %d, out %d, ws %zu); nothing launched\n", n_in, n_in > 0 ? in_sizes[0] : -1, out_size, ws_size); grid = -1; return; }
        int dev = 0, cus = 0, per_cu = 0;
        if (hipGetDevice(&dev) != hipSuccess || hipDeviceGetAttribute(&cus, hipDeviceAttributeMultiprocessorCount, dev) != hipSuccess) { grid = -1; return; }
        if (hipFuncSetAttribute((const void*)mk_fwd, hipFuncAttributeMaxDynamicSharedMemorySize, LDS_BYTES) != hipSuccess) { fprintf(stderr, "kernel_launch: hipFuncSetAttribute failed\n"); grid = -1; return; }
        if (hipOccupancyMaxActiveBlocksPerMultiprocessor(&per_cu, (const void*)mk_fwd, 512, LDS_BYTES) != hipSuccess || per_cu < 1) {
            fprintf(stderr, "kernel_launch: occupancy query reports %d workgroups per CU; nothing launched\n", per_cu); (void)hipGetLastError(); grid = -1; return; }
        grid = cus;
    }
    if (grid < 0) return;
    (void)hipMemsetAsync((char*)d_ws + WS_CTL, 0, CTL_ZERO_BYTES, stream);
    Args a{};
    for (int i = 0; i < 23; ++i) a.in[i] = (const float*)d_in[i];
    a.out = (float*)d_out; a.ws = (unsigned char*)d_ws;
    for (int i = 0; i < 8; ++i) a.invf[i] = (float)pow(500000.0, -0.125 * (double)i);
#if MK_LAUNCHES == 1
    a.ph_lo = 0; a.ph_hi = NPHASE;
    hipLaunchKernelGGL(mk_fwd, dim3(grid), dim3(512), LDS_BYTES, stream, a);
#else
    for (int p = 0; p < NPHASE; ++p) { a.ph_lo = p; a.ph_hi = p + 1; hipLaunchKernelGGL(mk_fwd, dim3(grid), dim3(512), LDS_BYTES, stream, a); }
#endif
}
```

```cpp
#include <hip/hip_runtime.h>
#include <cstdio>
#include <cstdint>
#include <cmath>

#ifndef P3REP
#define P3REP 0
#endif
#ifndef MK_LAUNCHES
#define MK_LAUNCHES 1
#endif

#define LAS __attribute__((address_space(3)))
#define GAS __attribute__((address_space(1)))
typedef unsigned short bf16;
typedef short bf16x8 __attribute__((ext_vector_type(8)));
typedef float f32x4 __attribute__((ext_vector_type(4)));
typedef float f32x16 __attribute__((ext_vector_type(16)));
typedef unsigned u32x4 __attribute__((ext_vector_type(4)));
typedef unsigned u32x2 __attribute__((ext_vector_type(2)));
typedef float f32x2_t __attribute__((ext_vector_type(2)));
typedef __bf16 bf16x2_t __attribute__((ext_vector_type(2)));

constexpr int BATCH = 2, SEQ = 8192, DM = 1024, MTOK = BATCH * SEQ;
constexpr int DIN = 5936, DINP = 6144;
constexpr int DFF = 2816, DFF2 = 5632;
constexpr float EPS = 1e-6f;
constexpr float LOG2E = 1.4426950408889634f;
constexpr float QSCALE = 0.125f * LOG2E;
constexpr float QXSCALE = 0.08838834764831845f * LOG2E;

constexpr size_t MiB = 1u << 20;
constexpr size_t WS_CTL = 0, CTL_ZERO_BYTES = 1 * MiB;
constexpr size_t WS_ROPE = 1 * MiB;
constexpr size_t WS_BIAS1 = 2 * MiB;
constexpr size_t WS_B1PART = 2 * MiB + 16 * 1024;
constexpr size_t WS_WC2T = 2 * MiB + 64 * 1024;
constexpr size_t WS_KC = 2 * MiB + 256 * 1024;
constexpr size_t WS_VCT = 2 * MiB + 512 * 1024;
constexpr size_t WS_MEMN = 3 * MiB;
constexpr size_t WS_MEMK = 4 * MiB;
constexpr size_t WS_MEMVT = 4 * MiB + 512 * 1024;
constexpr size_t WS_HID = 5 * MiB;
constexpr size_t WS_GNSA = 7 * MiB;
constexpr size_t WS_WCAT = 12 * MiB;
constexpr size_t WS_WOUT = 16 * MiB;
constexpr size_t WS_WUP = 18 * MiB;
constexpr size_t WS_WDOWN = 29 * MiB;
constexpr size_t WS_WMEM = 35 * MiB;
constexpr size_t WS_WC1 = 37 * MiB;
constexpr size_t WS_WIN = 39 * MiB;
constexpr size_t WS_KV = 51 * MiB;
constexpr size_t WS_Y = 39 * MiB;
constexpr size_t WS_F = 39 * MiB;
constexpr size_t WS_ACAT = 75 * MiB;
constexpr size_t WS_GBR = 139 * MiB;
constexpr size_t WS_A2 = 139 * MiB;
constexpr size_t WS_HALO = 227 * MiB;
constexpr size_t WS_END = 240 * MiB;
constexpr size_t KVSLAB = 2097152;

constexpr int CW_TMO = 0, CW_CODE = 1, CW_BAR = 4096;

constexpr int RING_BYTES = 143360;
constexpr int LDSCTL_OFF = RING_BYTES, MISC_OFF = LDSCTL_OFF + 320;
constexpr int LDS_BYTES = 145408;
constexpr int L_KB = 0, L_VB = 9216, L_IMP = 19456, L_SEL = 73728, L_YT = 74752;
constexpr int YT_STRIDE = 1040;
constexpr int IMP_STRIDE = 129;

__device__ __forceinline__ unsigned cvtpk(float lo, float hi) { f32x2_t v = {lo, hi}; bf16x2_t b = __builtin_convertvector(v, bf16x2_t); return __builtin_bit_cast(unsigned, b); }
__device__ __forceinline__ float bf2f(unsigned short b) { return __uint_as_float((unsigned)b << 16); }
__device__ __forceinline__ float bflo(unsigned w) { return __uint_as_float(w << 16); }
__device__ __forceinline__ float bfhi(unsigned w) { return __uint_as_float(w & 0xffff0000u); }
__device__ __forceinline__ unsigned short f2bf(float f) { return (unsigned short)(cvtpk(f, 0.f) & 0xffffu); }
__device__ __forceinline__ float wave_sum(float v) {
#pragma unroll
    for (int o = 1; o < 64; o <<= 1) v += __shfl_xor(v, o);
    return v;
}
__device__ __forceinline__ float sigmoidf_(float x) { return 1.0f / (1.0f + __builtin_amdgcn_exp2f(-x * LOG2E)); }
__device__ __forceinline__ float gelu_tanh(float x) {
    const float u2 = 1.5957691216057308f * (x + 0.044715f * x * x * x);
    return x / (1.0f + __builtin_amdgcn_exp2f(-u2 * LOG2E));
}
#define LDS_WAIT() asm volatile("s_waitcnt lgkmcnt(0)" ::: "memory")
#define VM_WAIT() asm volatile("s_waitcnt vmcnt(0)" ::: "memory")

namespace pg8 {
constexpr int BM = 256, BK = 64, HALF = 128, HTB = HALF * BK * 2, STAGE_BYTES = 8 * HTB, NXCD = 8, WGM = 8;
__host__ __device__ __forceinline__ int lds_byte(int r, int c) { const int st = (r >> 4) * 2 + (c >> 5), rr = r & 15, cc = c & 31, ob = rr * 64 + cc * 2; return st * 1024 + (ob ^ (((ob >> 9) & 1) << 5)); }
__host__ __device__ __forceinline__ void stage_rc(int b, int& R, int& C) { const int st = b / 1024, sb = b % 1024, swz = sb ^ (((sb >> 9) & 1) << 5); R = (st >> 1) * 16 + swz / 64; C = (st & 1) * 32 + (swz % 64) / 2; }
__host__ __device__ __forceinline__ int perm32(int rho) { const int n = rho >> 4, i = rho & 15; return 8 * (i >> 2) + 4 * n + (i & 3); }

struct Unit { int pm, pn, koff, nt, tag, boff; };
struct Gemm { const bf16* A; const bf16* Bt; int lda, ldb; };

__device__ __forceinline__ void tile_of(int wgid_in, int nM, int nN, int& pm, int& pn) {
    const int nwg = nM * nN; int wgid = wgid_in;
    { const int q = nwg / NXCD, r = nwg % NXCD, xcd = wgid % NXCD, off = wgid / NXCD; wgid = (xcd < r ? xcd * (q + 1) : r * (q + 1) + (xcd - r) * q) + off; }
    const int nig = WGM * nN, gid = wgid / nig, fm = gid * WGM, gsz = (nM - fm) < WGM ? (nM - fm) : WGM;
    pm = fm + ((wgid % nig) % gsz); pn = (wgid % nig) / gsz;
}
struct SchedGrid {
    int nM, nN, G, c, nt;
    __device__ __forceinline__ bool next(int i, Unit& u) const {
        const long L = (long)i * G + c; if (L >= (long)nM * nN) return false;
        tile_of((int)L, nM, nN, u.pm, u.pn); u.koff = 0; u.nt = nt; u.tag = 0; u.boff = 0; return true;
    }
};
struct SchedCat {
    int G, c;
    __device__ __forceinline__ bool next(int i, Unit& u) const {
        const int br = i % 3; const long L = (long)(i / 3) * G + c; if (L >= 256) return false;
        tile_of((int)L, 64, 4, u.pm, u.pn); u.koff = br == 0 ? 0 : (br == 1 ? 512 : 1536); u.nt = br == 1 ? 16 : 8; u.tag = br; u.boff = 0; return true;
    }
};
struct SchedCmp {
    int G, c;
    __device__ __forceinline__ bool next(int i, Unit& u) const {
        const long L = (long)i * G + c; if (L >= 16) return false;
        u.pm = (int)L; u.pn = 0; u.koff = 0; u.nt = 32; u.tag = u.pm >> 3; u.boff = u.tag * 256 * 2048; return true;
    }
};

#define PG8_SA(b, h) (((b) * 2 + (h)) * HTB)
#define PG8_SB(b, h) ((4 + (b) * 2 + (h)) * HTB)
#define PG8_STAGE(bufoff, gbase, voff) do { _Pragma("unroll") for (int _i = 0; _i < 2; ++_i) \
        __builtin_amdgcn_global_load_lds((const unsigned*)((const char*)(gbase) + (voff)[_i]), (LAS unsigned*)(lds + (bufoff) + ldsw + _i * 8192), 16, 0, 0); } while (0)
#define PG8_LDA(dst, b, h) do { _Pragma("unroll") for (int m = 0; m < 4; ++m) _Pragma("unroll") for (int k = 0; k < 2; ++k) dst[m][k] = *(const LAS bf16x8*)(lds + PG8_SA(b, h) + aoff + m * 2048 + k * 1024); } while (0)
#define PG8_LDB(dst, b, h) do { _Pragma("unroll") for (int n = 0; n < 2; ++n) _Pragma("unroll") for (int k = 0; k < 2; ++k) dst[n][k] = *(const LAS bf16x8*)(lds + PG8_SB(b, h) + boff + n * 2048 + k * 1024); } while (0)
#define PG8_MMA(ai, bj, At, Bt) do { __builtin_amdgcn_s_setprio(1); _Pragma("unroll") for (int m = 0; m < 4; ++m) _Pragma("unroll") for (int n = 0; n < 2; ++n) _Pragma("unroll") for (int k = 0; k < 2; ++k) \
        acc[ai][bj][m][n] = __builtin_amdgcn_mfma_f32_16x16x32_bf16(Bt[n][k], At[m][k], acc[ai][bj][m][n], 0, 0, 0); __builtin_amdgcn_s_setprio(0); } while (0)
#define PG8_WAIT_V(n) asm volatile("s_waitcnt vmcnt(" #n ")" ::: "memory")
#define PG8_WAIT_L(n) asm volatile("s_waitcnt lgkmcnt(" #n ")" ::: "memory")
#define PG8_BAR __builtin_amdgcn_s_barrier()
#define PG8_SCHED __builtin_amdgcn_sched_barrier(0)

template <class Epi, class Sched, bool ALIGN_EPI>
__device__ __forceinline__ void gemm_phase(LAS unsigned char* lds, const Gemm g, const Sched& S, const Epi& E) {
    int tid = threadIdx.x; asm volatile("" : "+v"(tid));
    const int wid = __builtin_amdgcn_readfirstlane(tid >> 6), lane = tid & 63, wr = wid >> 2, wc = wid & 3, fr = lane & 15, fq = lane >> 4;
    unsigned voffA[2], voffB[2];
#pragma unroll
    for (int i = 0; i < 2; ++i) { int R, C; stage_rc(tid * 16 + i * 8192, R, C); const int Rb = Epi::PERM ? ((R & ~31) + perm32(R & 31)) : R;
        voffA[i] = (unsigned)(R * g.lda + C) * 2u; voffB[i] = (unsigned)(Rb * g.ldb + C) * 2u; }
    const size_t kstep = (size_t)(BK * 2);
    const size_t hstepA = (size_t)HALF * g.lda * 2, hstepB = (size_t)HALF * g.ldb * 2;
    const unsigned ldsw = (unsigned)wid * 1024u;
    const int aoff = lds_byte(wr * 64 + fr, fq * 8), boff = lds_byte(wc * 32 + fr, fq * 8);
    Unit cur, nxt; int ui = 0;
    if (!S.next(0, cur)) return;
    f32x4 acc[2][2][4][2];
#pragma unroll
    for (int a = 0; a < 2; ++a)
#pragma unroll
        for (int b = 0; b < 2; ++b)
#pragma unroll
            for (int m = 0; m < 4; ++m)
#pragma unroll
                for (int n = 0; n < 2; ++n) acc[a][b][m][n] = (f32x4){0.f, 0.f, 0.f, 0.f};
    bf16x8 At[4][2], B0[2][2], B1[2][2];
    const char* cA = (const char*)g.A + ((size_t)cur.pm * 256 * g.lda + cur.koff) * 2;
    const char* cB = (const char*)g.Bt + ((size_t)cur.boff + (size_t)cur.pn * 256 * g.ldb + cur.koff) * 2;
    int nt = cur.nt;
    PG8_STAGE(PG8_SB(0, 0), cB, voffB); PG8_STAGE(PG8_SB(0, 1), cB + hstepB, voffB); PG8_STAGE(PG8_SA(0, 0), cA, voffA); PG8_STAGE(PG8_SA(0, 1), cA + hstepA, voffA);
    if (wr == 1) PG8_BAR;
    PG8_WAIT_V(2); PG8_BAR;
    PG8_STAGE(PG8_SB(1, 0), cB + kstep, voffB); PG8_STAGE(PG8_SA(1, 0), cA + kstep, voffA); PG8_STAGE(PG8_SB(1, 1), cB + hstepB + kstep, voffB);
    PG8_WAIT_V(6); PG8_BAR;
    for (;;) {
        const bool has_next = S.next(ui + 1, nxt);
        const char* nA = has_next ? (const char*)g.A + ((size_t)nxt.pm * 256 * g.lda + nxt.koff) * 2 : cA;
        const char* nB = has_next ? (const char*)g.Bt + ((size_t)nxt.boff + (size_t)nxt.pn * 256 * g.ldb + nxt.koff) * 2 : cB;
        for (int t = 0; t < nt; t += 2) {
            const bool last = (t == nt - 2);
            const char* a1 = cA + (size_t)(t + 1) * kstep;
            const char* a2 = last ? nA : cA + (size_t)(t + 2) * kstep; const char* b2 = last ? nB : cB + (size_t)(t + 2) * kstep;
            const char* a3 = a2 + kstep; const char* b3 = b2 + kstep;
            PG8_LDB(B0, 0, 0); PG8_LDB(B1, 0, 1); PG8_SCHED; PG8_LDA(At, 0, 0); PG8_STAGE(PG8_SA(1, 1), a1 + hstepA, voffA);
            PG8_WAIT_V(8); PG8_WAIT_L(0); PG8_BAR; PG8_MMA(0, 0, At, B0); PG8_MMA(0, 1, At, B1); PG8_BAR; PG8_SCHED;
            PG8_LDA(At, 0, 1); PG8_STAGE(PG8_SB(0, 0), b2, voffB); PG8_STAGE(PG8_SB(0, 1), b2 + hstepB, voffB); PG8_STAGE(PG8_SA(0, 0), a2, voffA);
            PG8_WAIT_V(8); PG8_WAIT_L(0); PG8_BAR; PG8_MMA(1, 0, At, B0); PG8_MMA(1, 1, At, B1); PG8_BAR; PG8_SCHED;
            PG8_LDB(B0, 1, 0); PG8_LDB(B1, 1, 1); PG8_SCHED; PG8_LDA(At, 1, 0); PG8_STAGE(PG8_SA(0, 1), a2 + hstepA, voffA);
            PG8_WAIT_V(8); PG8_WAIT_L(0); PG8_BAR; PG8_MMA(0, 0, At, B0); PG8_MMA(0, 1, At, B1); PG8_BAR; PG8_SCHED;
            PG8_LDA(At, 1, 1); PG8_STAGE(PG8_SB(1, 0), b3, voffB); PG8_STAGE(PG8_SB(1, 1), b3 + hstepB, voffB); PG8_STAGE(PG8_SA(1, 0), a3, voffA);
            PG8_WAIT_V(8); PG8_WAIT_L(0); PG8_BAR; PG8_MMA(1, 0, At, B0); PG8_MMA(1, 1, At, B1); PG8_BAR; PG8_SCHED;
        }
        if constexpr (ALIGN_EPI) { if (wr == 0) PG8_BAR; }
        E(acc, cur, wr, wc, fr, fq);
        if (!has_next) break;
        if (!Epi::keeps(cur)) {
#pragma unroll
        for (int a = 0; a < 2; ++a)
#pragma unroll
            for (int b = 0; b < 2; ++b)
#pragma unroll
                for (int m = 0; m < 4; ++m)
#pragma unroll
                    for (int n = 0; n < 2; ++n) acc[a][b][m][n] = (f32x4){0.f, 0.f, 0.f, 0.f};
        }
        cur = nxt; cA = nA; cB = nB; nt = cur.nt; ++ui;
        if constexpr (ALIGN_EPI) { if (wr == 1) PG8_BAR; }
    }
    PG8_WAIT_V(0);
    if constexpr (!ALIGN_EPI) { if (wr == 0) PG8_BAR; }
    PG8_BAR;
}

struct EpiF32 {
    static constexpr bool PERM = false;
    static __device__ __forceinline__ bool keeps(const Unit&) { return false; }
    float* C; int ldc;
    __device__ __forceinline__ void operator()(f32x4 (&acc)[2][2][4][2], const Unit& u, int wr, int wc, int fr, int fq) const {
        const int row0 = u.pm * BM + wr * 64 + fr, col0 = u.pn * BM + wc * 32 + 4 * fq;
#pragma unroll
        for (int ai = 0; ai < 2; ++ai)
#pragma unroll
            for (int m = 0; m < 4; ++m) { float* rowp = C + (size_t)(row0 + ai * HALF + m * 16) * ldc + col0;
#pragma unroll
                for (int bj = 0; bj < 2; ++bj)
#pragma unroll
                    for (int n = 0; n < 2; ++n) *(f32x4*)(rowp + bj * HALF + n * 16) = acc[ai][bj][m][n]; }
    }
};

struct EpiCmp {
    static constexpr bool PERM = true;
    static __device__ __forceinline__ bool keeps(const Unit&) { return false; }
    bf16* H; const float* bias1;
    __device__ __forceinline__ void operator()(f32x4 (&acc)[2][2][4][2], const Unit& u, int wr, int wc, int fr, int fq) const {
        const int row0 = u.pm * BM + wr * 64 + fr, col0 = wc * 32 + 8 * fq;
        const float* bz = bias1 + u.tag * 256;
#pragma unroll
        for (int bj = 0; bj < 2; ++bj) {
            const f32x4 b0 = *(const f32x4*)(bz + col0 + bj * HALF), b1 = *(const f32x4*)(bz + col0 + bj * HALF + 4);
#pragma unroll
            for (int ai = 0; ai < 2; ++ai)
#pragma unroll
                for (int m = 0; m < 4; ++m) {
                    const f32x4 v0 = acc[ai][bj][m][0] + b0, v1 = acc[ai][bj][m][1] + b1;
                    u32x4 w; w.x = cvtpk(gelu_tanh(v0[0]), gelu_tanh(v0[1])); w.y = cvtpk(gelu_tanh(v0[2]), gelu_tanh(v0[3]));
                    w.z = cvtpk(gelu_tanh(v1[0]), gelu_tanh(v1[1])); w.w = cvtpk(gelu_tanh(v1[2]), gelu_tanh(v1[3]));
                    *(u32x4*)(H + (size_t)(row0 + ai * HALF + m * 16) * 256 + col0 + bj * HALF) = w;
                }
        }
    }
};

struct EpiMemKV {
    static constexpr bool PERM = true;
    static __device__ __forceinline__ bool keeps(const Unit&) { return false; }
    bf16* MK; bf16* MVT;
    __device__ __forceinline__ void operator()(f32x4 (&acc)[2][2][4][2], const Unit& u, int wr, int wc, int fr, int fq) const {
        const int row0 = u.pm * BM + wr * 64 + fr;
#pragma unroll
        for (int bj = 0; bj < 2; ++bj) {
            const int col = u.pn * BM + bj * HALF + wc * 32 + 8 * fq;
            const int kvsel = col >> 9, head = (col >> 7) & 3, d0 = col & 127;
#pragma unroll
            for (int ai = 0; ai < 2; ++ai)
#pragma unroll
                for (int m = 0; m < 4; ++m) {
                    const int row = row0 + ai * HALF + m * 16, b = row >> 8, mm = row & 255;
                    const f32x4 v0 = acc[ai][bj][m][0], v1 = acc[ai][bj][m][1];
                    if (kvsel == 0) {
                        u32x4 w; w.x = cvtpk(v0[0], v0[1]); w.y = cvtpk(v0[2], v0[3]); w.z = cvtpk(v1[0], v1[1]); w.w = cvtpk(v1[2], v1[3]);
                        *(u32x4*)(MK + ((size_t)((b * 4 + head) * 256 + mm)) * 128 + d0) = w;
                    } else {
                        const int kk = mm & 31, pos = (kk & 16) | (kk & 3) | (((kk >> 3) & 1) << 2) | (((kk >> 2) & 1) << 3);
                        bf16* base = MVT + ((size_t)((b * 4 + head) * 8 + (mm >> 5)) * 128 + d0) * 32 + pos;
#pragma unroll
                        for (int e = 0; e < 4; ++e) { base[(size_t)e * 32] = f2bf(v0[e]); base[(size_t)(e + 4) * 32] = f2bf(v1[e]); }
                    }
                }
        }
    }
};

struct EpiIn {
    static constexpr bool PERM = true;
    static __device__ __forceinline__ bool keeps(const Unit&) { return false; }
    bf16* upool; bf16* q; bf16* qx; bf16* gbr; float* gnsa; bf16* kv; const float* rope;
    __device__ __forceinline__ void operator()(f32x4 (&acc_in)[2][2][4][2], const Unit& u, int wr, int wc, int fr, int fq) const {
        const int pn = u.pn, row0 = u.pm * BM + wr * 64 + fr, cl = wc * 32 + 8 * fq;
        const bool rotw = (pn >= 2 && pn < 9) && ((wc & 1) == 0);
#pragma unroll
        for (int ai = 0; ai < 2; ++ai)
#pragma unroll
            for (int m = 0; m < 4; ++m) {
                const int row = row0 + ai * HALF + m * 16;
#pragma unroll
                for (int bj = 0; bj < 2; ++bj) {
                    f32x4 v0 = acc_in[ai][bj][m][0], v1 = acc_in[ai][bj][m][1];
                    const bool rot_here = rotw && (pn < 6 || bj == 0);
                    if (rot_here) {
                        f32x4 y0, y1;
#pragma unroll
                        for (int e = 0; e < 4; ++e) { y0[e] = __shfl_xor(v0[e], 16); y1[e] = __shfl_xor(v1[e], 16); }
                        if (fq < 2) {
                            const f32x4 c0 = *(const f32x4*)(rope + (size_t)row * 16), c1 = *(const f32x4*)(rope + (size_t)row * 16 + 4);
                            const f32x4 s0 = *(const f32x4*)(rope + (size_t)row * 16 + 8), s1 = *(const f32x4*)(rope + (size_t)row * 16 + 12);
                            const float sg = fq == 0 ? -1.f : 1.f;
                            v0 = v0 * c0 + sg * (y0 * s0); v1 = v1 * c1 + sg * (y1 * s1);
                        }
                    }
                    if (pn < 2) {
                        u32x4 w; w.x = cvtpk(v0[0], v0[1]); w.y = cvtpk(v0[2], v0[3]); w.z = cvtpk(v1[0], v1[1]); w.w = cvtpk(v1[2], v1[3]);
                        *(u32x4*)(upool + (size_t)row * 512 + pn * 256 + bj * HALF + cl) = w;
                    } else if (pn < 6) {
                        v0 = v0 * QSCALE; v1 = v1 * QSCALE;
                        u32x4 w; w.x = cvtpk(v0[0], v0[1]); w.y = cvtpk(v0[2], v0[3]); w.z = cvtpk(v1[0], v1[1]); w.w = cvtpk(v1[2], v1[3]);
                        *(u32x4*)(q + (size_t)row * 1024 + (pn - 2) * 256 + bj * HALF + cl) = w;
                    } else if (pn < 9) {
                        const int j = 2 * (pn - 6) + bj, gg = wc >> 1, d0 = (wc & 1) * 32 + 8 * fq, b = row >> 13, t = row & 8191;
                        bf16* slab = kv + (size_t)j * KVSLAB;
                        if (j == 3) {
                            const int kk = t & 63, pos = (kk & 32) | (kk & 3) | (((kk >> 4) & 1) << 2) | (((kk >> 2) & 3) << 3);
                            bf16* base = slab + ((size_t)((b * 2 + gg) * 128 + (t >> 6)) * 64 + d0) * 64 + pos;
#pragma unroll
                            for (int e = 0; e < 4; ++e) { base[(size_t)e * 64] = f2bf(v0[e]); base[(size_t)(e + 4) * 64] = f2bf(v1[e]); }
                        } else if (j == 5) {
                            const int kk = t & 31, pos = (kk & 16) | (kk & 3) | (((kk >> 3) & 1) << 2) | (((kk >> 2) & 1) << 3);
                            bf16* base = slab + ((size_t)((b * 2 + gg) * 256 + (t >> 5)) * 64 + d0) * 32 + pos;
#pragma unroll
                            for (int e = 0; e < 4; ++e) { base[(size_t)e * 32] = f2bf(v0[e]); base[(size_t)(e + 4) * 32] = f2bf(v1[e]); }
                        } else {
                            u32x4 w; w.x = cvtpk(v0[0], v0[1]); w.y = cvtpk(v0[2], v0[3]); w.z = cvtpk(v1[0], v1[1]); w.w = cvtpk(v1[2], v1[3]);
                            *(u32x4*)(slab + ((size_t)((b * 2 + gg) * 8192 + t)) * 64 + d0) = w;
                        }
                    } else if (pn == 9) {
                        const int c0 = bj * HALF + cl;
#pragma unroll
                        for (int e = 0; e < 4; ++e) { if (c0 + e < 48) gnsa[(size_t)row * 48 + c0 + e] = sigmoidf_(v0[e]); if (c0 + 4 + e < 48) gnsa[(size_t)row * 48 + c0 + 4 + e] = sigmoidf_(v1[e]); }
                    } else if (pn < 12) {
                        v0 = v0 * QXSCALE; v1 = v1 * QXSCALE;
                        u32x4 w; w.x = cvtpk(v0[0], v0[1]); w.y = cvtpk(v0[2], v0[3]); w.z = cvtpk(v1[0], v1[1]); w.w = cvtpk(v1[2], v1[3]);
                        *(u32x4*)(qx + (size_t)row * 512 + (pn - 10) * 256 + bj * HALF + cl) = w;
                    } else {
                        u32x4 w; w.x = cvtpk(sigmoidf_(v0[0]), sigmoidf_(v0[1])); w.y = cvtpk(sigmoidf_(v0[2]), sigmoidf_(v0[3]));
                        w.z = cvtpk(sigmoidf_(v1[0]), sigmoidf_(v1[1])); w.w = cvtpk(sigmoidf_(v1[2]), sigmoidf_(v1[3]));
                        *(u32x4*)(gbr + (size_t)row * 3072 + (pn - 12) * 256 + bj * HALF + cl) = w;
                    }
                }
            }
    }
};

struct EpiGate {
    static constexpr bool PERM = true;
    static __device__ __forceinline__ bool keeps(const Unit& u) { return u.tag != 2; }
    const bf16* gbr; bf16* Y;
    __device__ __forceinline__ void operator()(f32x4 (&acc)[2][2][4][2], const Unit& u, int wr, int wc, int fr, int fq) const {
        const int row0 = u.pm * BM + wr * 64 + fr, br = u.tag;
        constexpr float GMIN = 5.9604645e-8f;
#pragma unroll
        for (int ai = 0; ai < 2; ++ai)
#pragma unroll
            for (int m = 0; m < 4; ++m) {
                const int row = row0 + ai * HALF + m * 16;
#pragma unroll
                for (int bj = 0; bj < 2; ++bj) {
                    const int col = u.pn * BM + bj * HALF + wc * 32 + 8 * fq;
                    const u32x4 gw = *(const u32x4*)(gbr + (size_t)row * 3072 + br * 1024 + col);
                    float f[8] = {bflo(gw.x), bfhi(gw.x), bflo(gw.y), bfhi(gw.y), bflo(gw.z), bfhi(gw.z), bflo(gw.w), bfhi(gw.w)};
#pragma unroll
                    for (int e = 0; e < 8; ++e) f[e] = fmaxf(f[e], GMIN);
                    if (br != 2) {
                        const u32x4 gn = *(const u32x4*)(gbr + (size_t)row * 3072 + (br + 1) * 1024 + col);
                        const float d[8] = {bflo(gn.x), bfhi(gn.x), bflo(gn.y), bfhi(gn.y), bflo(gn.z), bfhi(gn.z), bflo(gn.w), bfhi(gn.w)};
#pragma unroll
                        for (int e = 0; e < 8; ++e) f[e] = f[e] * __builtin_amdgcn_rcpf(fmaxf(d[e], GMIN));
                    }
                    f32x4 v0 = acc[ai][bj][m][0], v1 = acc[ai][bj][m][1];
#pragma unroll
                    for (int e = 0; e < 4; ++e) { v0[e] *= f[e]; v1[e] *= f[4 + e]; }
                    if (br != 2) { acc[ai][bj][m][0] = v0; acc[ai][bj][m][1] = v1; }
                    else { u32x4 w; w.x = cvtpk(v0[0], v0[1]); w.y = cvtpk(v0[2], v0[3]); w.z = cvtpk(v1[0], v1[1]); w.w = cvtpk(v1[2], v1[3]);
                           *(u32x4*)(Y + (size_t)row * 1024 + col) = w; }
                }
            }
    }
};

struct EpiConv {
    static constexpr bool PERM = true;
    static __device__ __forceinline__ bool keeps(const Unit&) { return false; }
    bf16* A2; bf16* halo; const float* cw; const float* cb;
    __device__ __forceinline__ void operator()(f32x4 (&acc)[2][2][4][2], const Unit& u, int wr, int wc, int fr, int fq) const {
        const int lane = threadIdx.x & 63;
        const int src1 = (lane & 48) | ((fr - 1) & 15), src2 = (lane & 48) | ((fr - 2) & 15);
        const int chb = u.pn * 128 + wc * 32 + 8 * fq;
        const int ncol0 = u.pn * 256 + wc * 32 + 8 * fq;
#pragma unroll
        for (int n = 0; n < 2; ++n) {
            const int ch = chb + 4 * n;
            f32x4 w0[2], w1[2], w2[2], bb[2];
#pragma unroll
            for (int bj = 0; bj < 2; ++bj) { const int ci = bj * DFF + ch;
                w0[bj] = *(const f32x4*)(cw + ci); w1[bj] = *(const f32x4*)(cw + DFF2 + ci); w2[bj] = *(const f32x4*)(cw + 2 * DFF2 + ci); bb[bj] = *(const f32x4*)(cb + ci); }
#pragma unroll
            for (int ai = 0; ai < 2; ++ai) {
                const int kk = 4 * u.pm + 2 * ai + wr;
#pragma unroll
                for (int m = 0; m < 4; ++m) {
                    const int row = kk * 64 + m * 16 + fr;
                    f32x4 cv[2];
#pragma unroll
                    for (int bj = 0; bj < 2; ++bj) {
                        const f32x4 cur = acc[ai][bj][m][n];
                        const f32x4 prv = m > 0 ? acc[ai][bj][m - 1][n] : (f32x4){0.f, 0.f, 0.f, 0.f};
                        f32x4 u1, u2;
#pragma unroll
                        for (int e = 0; e < 4; ++e) {
                            const float d1 = fr == 15 ? prv[e] : cur[e];
                            const float d2 = fr >= 14 ? prv[e] : cur[e];
                            u1[e] = __shfl(d1, src1); u2[e] = __shfl(d2, src2);
                        }
                        cv[bj] = bb[bj] + w0[bj] * u2 + w1[bj] * u1 + w2[bj] * cur;
                        if ((m == 3 && fr >= 14) || (m == 0 && fr < 2)) {
                            const int hk = m == 3 ? kk + 1 : kk, hr = m == 3 ? fr - 14 : 2 + fr;
                            u32x2 w; w.x = cvtpk(cur[0], cur[1]); w.y = cvtpk(cur[2], cur[3]);
                            *(u32x2*)(halo + ((size_t)(hk * 4 + hr)) * DFF2 + ncol0 + bj * HALF + 4 * n) = w;
                        }
                    }
                    if (!(m == 0 && fr < 2)) {
                        u32x2 w; w.x = cvtpk(gelu_tanh(cv[0][0]) * cv[1][0], gelu_tanh(cv[0][1]) * cv[1][1]);
                        w.y = cvtpk(gelu_tanh(cv[0][2]) * cv[1][2], gelu_tanh(cv[0][3]) * cv[1][3]);
                        *(u32x2*)(A2 + (size_t)row * DFF + ch) = w;
                    }
                }
            }
        }
    }
};
}

typedef GAS unsigned gu32;
#define RLX_AGENT __ATOMIC_RELAXED, __HIP_MEMORY_SCOPE_AGENT
#define XB_TMO      128
#define XB_XCNT(j)  (256  + 64 * (j))
#define XB_XSUB(j)  (1280 + 64 * (j))
#define XB_XGEN(j)  (2304 + 64 * (j))
#define XB_TOP      3328
#define XB_TOPGEN   3392
#define XCD_BAR_WORDS 3456
#define XB_SPIN_CAP (1u << 22)
__device__ __forceinline__ unsigned xb_ld(unsigned* p)              { return __hip_atomic_load(p, __ATOMIC_RELAXED, __HIP_MEMORY_SCOPE_AGENT); }
__device__ __forceinline__ unsigned xb_add(unsigned* p, unsigned v) { return __hip_atomic_fetch_add(p, v, __ATOMIC_RELAXED, __HIP_MEMORY_SCOPE_AGENT); }
__device__ __forceinline__ unsigned xb_xcc_id() { return (unsigned)__builtin_amdgcn_s_getreg((3 << 11) | 20) & 0xFu; }
#define XB_SPIN(cond, bar) do { unsigned _sp = 0; while (cond) { __builtin_amdgcn_s_sleep(1); \
    if ((++_sp & 255u) == 0u) { if (xb_ld(&(bar)[XB_TMO])) break; if (_sp > XB_SPIN_CAP) { atomicAdd(&(bar)[XB_TMO], 1u); break; } } } } while (0)
struct XcdBarrier { unsigned* bar; unsigned x; volatile LAS unsigned* st; };
__device__ __forceinline__ XcdBarrier xcd_barrier_post(unsigned* bar, volatile LAS unsigned* st) {
    XcdBarrier b; b.bar = bar; b.x = xb_xcc_id(); b.st = st;
    if (threadIdx.x == 0) (void)xb_add(&bar[XB_XCNT(b.x)], 1u);
    return b;
}
__device__ __forceinline__ void xcd_barrier_complete(unsigned* bar, unsigned x, unsigned& nloc, unsigned& nx) {
    const unsigned G = gridDim.x * gridDim.y * gridDim.z;
    unsigned sum, cnt, mine, sp = 0u;
    for (;;) {
        sum = 0u; cnt = 0u; mine = 0u;
#pragma unroll
        for (unsigned j = 0; j < 16; ++j) { const unsigned c = xb_ld(&bar[XB_XCNT(j)]); sum += c; cnt += (c > 0u) ? 1u : 0u; mine = (j == x) ? c : mine; }
        if (sum == G) break;
        __builtin_amdgcn_s_sleep(1);
        if ((++sp & 255u) == 0u) { if (xb_ld(&bar[XB_TMO])) break; if (sp > XB_SPIN_CAP) { atomicAdd(&bar[XB_TMO], 1u); break; } }
    }
    nloc = mine > 0u ? mine : 1u; nx = cnt > 0u ? cnt : 1u;
}
__device__ __forceinline__ void xcd_barrier(const XcdBarrier& b) {
    asm volatile("s_waitcnt vmcnt(0)" ::: "memory");
    __syncthreads();
    if (threadIdx.x == 0) {
        unsigned* bar = b.bar;
        __builtin_amdgcn_s_waitcnt(0);
        unsigned nloc = b.st[0], nx = b.st[1];
        if (nloc == 0u) { xcd_barrier_complete(bar, b.x, nloc, nx); b.st[0] = nloc; b.st[1] = nx; }
        const unsigned old = xb_add(&bar[XB_XSUB(b.x)], 1u);
        const unsigned gen = old / nloc;
        if (old + 1u == (gen + 1u) * nloc) {
            __builtin_amdgcn_fence(__ATOMIC_RELEASE, "agent");
            asm volatile("s_waitcnt vmcnt(0)" ::: "memory");
            const unsigned og = xb_add(&bar[XB_TOP], 1u);
            const unsigned tg = og / nx;
            if (og + 1u == (tg + 1u) * nx) xb_add(&bar[XB_TOPGEN], 1u);
            else XB_SPIN(xb_ld(&bar[XB_TOPGEN]) == tg, bar);
            __builtin_amdgcn_fence(__ATOMIC_ACQUIRE, "agent");
            xb_add(&bar[XB_XGEN(b.x)], 1u);
            asm volatile("s_waitcnt vmcnt(0)" ::: "memory");
        } else {
            XB_SPIN(xb_ld(&bar[XB_XGEN(b.x)]) == gen, bar);
            __builtin_amdgcn_fence(__ATOMIC_ACQUIRE, "agent");
            asm volatile("s_waitcnt vmcnt(0)" ::: "memory");
        }
    }
    __syncthreads();
}

struct Args {
    const float* in[23]; float* out; unsigned char* ws;
    float invf[8];
    int ph_lo, ph_hi;
};

struct Frame {
    LAS unsigned char* lds;
    int tid, lane, wave, vcu, G, bx;
};

template <class Map>
__device__ __forceinline__ void transpose_item(const float* W, int N, bf16* WT, int ldt, int koff, LAS float* scr, int nblk, int item, int lane, Map map) {
    const int kb = item / nblk, nb = item % nblk, k0 = 64 * kb, n0 = 32 * nb;
    const int sc = map(n0 + (lane & 31));
#pragma unroll 8
    for (int i = 0; i < 32; ++i) { const int kk = 2 * i + (lane >> 5); scr[kk * 33 + (lane & 31)] = sc >= 0 ? W[(size_t)(k0 + kk) * N + sc] : 0.f; }
    LDS_WAIT(); asm volatile("" ::: "memory");
    const int c = lane & 7;
#pragma unroll
    for (int j = 0; j < 4; ++j) { const int n = (lane >> 3) + 8 * j; const LAS float* s = scr + (8 * c) * 33 + n;
        u32x4 o; o.x = cvtpk(s[0 * 33], s[1 * 33]); o.y = cvtpk(s[2 * 33], s[3 * 33]); o.z = cvtpk(s[4 * 33], s[5 * 33]); o.w = cvtpk(s[6 * 33], s[7 * 33]);
        *(u32x4*)(WT + (size_t)(n0 + n) * ldt + koff + k0 + 8 * c) = o; }
    LDS_WAIT(); asm volatile("" ::: "memory");
}
struct MapId { __device__ __forceinline__ int operator()(int n) const { return n; } };
struct MapIn { __device__ __forceinline__ int operator()(int n) const { return n < 2352 ? n : (n < 2560 ? -1 : n - 208); } };
struct MapUp { __device__ __forceinline__ int operator()(int n) const { const int pn = n >> 8, r = n & 255; return r < 128 ? pn * 128 + r : DFF + pn * 128 + r - 128; } };

__device__ __forceinline__ void rms_row_to_bf16(const float* xrow, const float* g, bf16* orow, int lane) {
    const f32x4* xr = (const f32x4*)xrow + lane; const f32x4* gr = (const f32x4*)g + lane;
    f32x4 v[4]; float s = 0.f;
#pragma unroll
    for (int j = 0; j < 4; ++j) { v[j] = xr[64 * j]; s += (v[j].x * v[j].x + v[j].y * v[j].y) + (v[j].z * v[j].z + v[j].w * v[j].w); }
    const float rstd = 1.0f / sqrtf(wave_sum(s) * (1.f / DM) + EPS);
    u32x2* o8 = (u32x2*)orow + lane;
#pragma unroll
    for (int j = 0; j < 4; ++j) { const f32x4 gg = gr[64 * j]; u32x2 w; w.x = cvtpk(v[j].x * rstd * gg.x, v[j].y * rstd * gg.y); w.y = cvtpk(v[j].z * rstd * gg.z, v[j].w * rstd * gg.w); o8[64 * j] = w; }
}

__device__ __forceinline__ int krow(int reg, int h) { return (reg & 3) + 8 * (reg >> 2) + 4 * h; }

struct MaskCmp { int tq[2]; __device__ __forceinline__ bool operator()(int T, int kr, int qb) const { return 16 * (32 * T + kr) + 31 <= tq[qb]; }
    __device__ __forceinline__ bool interior(int) const { return false; } };
struct MaskWin { int tq[2]; int base; __device__ __forceinline__ bool operator()(int T, int kr, int qb) const { const int kp = base + 32 * T + kr; return kp <= tq[qb] && tq[qb] - kp < 512; }
    __device__ __forceinline__ bool interior(int T) const { return T >= 2 && T <= 15; } };
struct MaskNone { __device__ __forceinline__ bool operator()(int, int, int) const { return true; }
    __device__ __forceinline__ bool interior(int) const { return true; } };

template <int HD, int NQB, bool IMP, class Mask>
__device__ __forceinline__ void attn2pass(LAS unsigned char* lds, const bf16* Kg, const bf16* Vg, int T0, int T1, const bf16x8 (&Qf)[NQB][HD / 16],
                                          const Mask& mask, const float (&gate)[NQB], f32x16 (&O)[HD / 32][NQB], LAS unsigned* imp, int tid, int lane) {
    asm volatile("" : "+v"(tid)); lane = tid & 63;
    constexpr int KSTR = HD * 2 + 16, VSTR = 80, KBYTES = 32 * KSTR, VBYTES = HD * VSTR;
    constexpr int KCH = 32 * HD * 2 / 16, VCH = KCH;
    constexpr int CPR = HD * 2 / 16;
    LAS unsigned char* KB = lds; LAS unsigned char* VB = lds + 2 * KBYTES;
    const int r32 = lane & 31, h = lane >> 5;
    float mrun[NQB], lrun[NQB];
#pragma unroll
    for (int qb = 0; qb < NQB; ++qb) { mrun[qb] = -1e29f; lrun[qb] = 0.f; }
    static_assert(KCH + VCH <= 512, "attn2pass: K and V tiles are staged by disjoint thread halves");
    u32x4 kreg[3];
    const int Tl = T1 - 1;
    const bool isv = tid >= KCH; const int vi = tid - KCH;
    const bf16* kp_ = Kg + (isv ? 0 : tid) * 8;
    const bf16* kv_ = isv ? Vg + vi * 8 : Kg + tid * 8;
    const int kdst = (tid / CPR) * KSTR + (tid % CPR) * 16;
    const int kvdst = isv ? 2 * KBYTES + (vi >> 2) * VSTR + (vi & 3) * 16 : kdst, kvbuf = isv ? VBYTES : KBYTES;
#pragma unroll
    for (int u = 0; u < 3; ++u) { const int Tc = (T0 + u < Tl) ? T0 + u : Tl; kreg[u] = *(const u32x4*)(kp_ + (size_t)Tc * 32 * HD); }
    for (int Tb = T0; Tb < T1; Tb += 3) {
#pragma unroll
      for (int u = 0; u < 3; ++u) { const int T = Tb + u;
        if (!isv) *(LAS u32x4*)(lds + kdst + (T & 1) * KBYTES) = kreg[u];
        __syncthreads();
        { const int Tc = (T + 3 < Tl) ? T + 3 : Tl; kreg[u] = *(const u32x4*)(kp_ + (size_t)Tc * 32 * HD); }
        if (T < T1) {
        const LAS unsigned char* kb = KB + (T & 1) * KBYTES + r32 * KSTR + h * 16;
        f32x16 S[NQB];
#pragma unroll
        for (int qb = 0; qb < NQB; ++qb) S[qb] = (f32x16){0.f,0.f,0.f,0.f,0.f,0.f,0.f,0.f,0.f,0.f,0.f,0.f,0.f,0.f,0.f,0.f};
#pragma unroll
        for (int s = 0; s < HD / 16; ++s) { const bf16x8 kf = *(const LAS bf16x8*)(kb + s * 32);
#pragma unroll
            for (int qb = 0; qb < NQB; ++qb) S[qb] = __builtin_amdgcn_mfma_f32_32x32x16_bf16(kf, Qf[qb][s], S[qb], 0, 0, 0); }
#pragma unroll
        for (int qb = 0; qb < NQB; ++qb) {
            float tm = -1e30f;
#pragma unroll
            for (int r = 0; r < 16; ++r) { S[qb][r] = mask(T, krow(r, h), qb) ? S[qb][r] : -1e30f; tm = fmaxf(tm, S[qb][r]); }
            const float mn = fmaxf(mrun[qb], tm);
            float sum = 0.f;
#pragma unroll
            for (int r = 0; r < 16; ++r) sum += __builtin_amdgcn_exp2f(S[qb][r] - mn);
            lrun[qb] = lrun[qb] * __builtin_amdgcn_exp2f(mrun[qb] - mn) + sum; mrun[qb] = mn;
        }
      } }
    }
    float inv[NQB];
#pragma unroll
    for (int qb = 0; qb < NQB; ++qb) {
        const float mo = __shfl_xor(mrun[qb], 32), lo = __shfl_xor(lrun[qb], 32);
        const float M = fmaxf(mrun[qb], mo);
        const float L = lrun[qb] * __builtin_amdgcn_exp2f(mrun[qb] - M) + lo * __builtin_amdgcn_exp2f(mo - M);
        mrun[qb] = M; inv[qb] = L > 0.f ? 1.0f / L : 0.f;
    }
    __syncthreads();
#pragma unroll
    for (int u = 0; u < 3; ++u) { const int Tc = (T0 + u < Tl) ? T0 + u : Tl; kreg[u] = *(const u32x4*)(kv_ + (size_t)Tc * 32 * HD); }
    for (int Tb = T0; Tb < T1; Tb += 3) {
#pragma unroll
      for (int u = 0; u < 3; ++u) { const int T = Tb + u;
        *(LAS u32x4*)(lds + kvdst + (T & 1) * kvbuf) = kreg[u];
        __syncthreads();
        { const int Tc = (T + 3 < Tl) ? T + 3 : Tl; kreg[u] = *(const u32x4*)(kv_ + (size_t)Tc * 32 * HD); }
        if (T < T1) {
        const LAS unsigned char* kb = KB + (T & 1) * KBYTES + r32 * KSTR + h * 16;
        const LAS unsigned char* vb = VB + (T & 1) * VBYTES + r32 * VSTR + h * 16;
#pragma unroll
        for (int qb = 0; qb < NQB; ++qb) {
            f32x16 p = (f32x16){0.f,0.f,0.f,0.f,0.f,0.f,0.f,0.f,0.f,0.f,0.f,0.f,0.f,0.f,0.f,0.f};
#pragma unroll
            for (int s = 0; s < HD / 16; ++s) { const bf16x8 kf = *(const LAS bf16x8*)(kb + s * 32);
                p = __builtin_amdgcn_mfma_f32_32x32x16_bf16(kf, Qf[qb][s], p, 0, 0, 0); }
#pragma unroll
            for (int r = 0; r < 16; ++r) { const float sv = mask(T, krow(r, h), qb) ? p[r] : -1e30f; p[r] = __builtin_amdgcn_exp2f(sv - mrun[qb]) * inv[qb]; }
            if constexpr (IMP) {
                const int qrow = (32 * qb + r32) * IMP_STRIDE;
#pragma unroll
                for (int a = 0; a < 4; ++a) {
                    const int jp = 8 * T + 2 * a + h;
                    const float g4 = (p[4 * a] + p[4 * a + 1]) + (p[4 * a + 2] + p[4 * a + 3]), e3 = p[4 * a + 3];
                    if (g4 > 0.f) {
                        atomicAdd((unsigned*)(imp + qrow + jp), (unsigned)(g4 * 16777216.f + 0.5f));
                        if (jp + 1 < 128) atomicAdd((unsigned*)(imp + qrow + jp + 1), (unsigned)(e3 * 16777216.f + 0.5f));
                    }
                }
            }
            const float gt = gate[qb];
            bf16x8 Pf[2];
#pragma unroll
            for (int s2 = 0; s2 < 2; ++s2) { u32x4 w; w.x = cvtpk(p[8 * s2] * gt, p[8 * s2 + 1] * gt); w.y = cvtpk(p[8 * s2 + 2] * gt, p[8 * s2 + 3] * gt);
                w.z = cvtpk(p[8 * s2 + 4] * gt, p[8 * s2 + 5] * gt); w.w = cvtpk(p[8 * s2 + 6] * gt, p[8 * s2 + 7] * gt); Pf[s2] = __builtin_bit_cast(bf16x8, w); }
#pragma unroll
            for (int db = 0; db < HD / 32; ++db)
#pragma unroll
                for (int s2 = 0; s2 < 2; ++s2) { const bf16x8 vf = *(const LAS bf16x8*)(vb + db * 32 * VSTR + s2 * 32);
                    O[db][qb] = __builtin_amdgcn_mfma_f32_32x32x16_bf16(vf, Pf[s2], O[db][qb], 0, 0, 0); }
        }
      } }
    }
    __syncthreads();
}

template <int HD, int NQB, class Mask>
__device__ __forceinline__ void attn1pass(LAS unsigned char* lds, const bf16* Kg, const bf16* Vg, int T0, int T1, const bf16x8 (&Qf)[NQB][HD / 16],
                                          const Mask& mask, f32x16 (&O)[HD / 32][NQB], float (&Lout)[NQB], int tid, int lane) {
    asm volatile("" : "+v"(tid)); lane = tid & 63;
    constexpr int KSTR = HD * 2 + 16, VSTR = 80, KBYTES = 32 * KSTR, VBYTES = HD * VSTR;
    constexpr int KCH = 32 * HD * 2 / 16, VCH = KCH, CPR = HD * 2 / 16;
    LAS unsigned char* KB = lds; LAS unsigned char* VB = lds + 2 * KBYTES;
    const int r32 = lane & 31, h = lane >> 5;
    float mrun[NQB], lrun[NQB];
#pragma unroll
    for (int qb = 0; qb < NQB; ++qb) { mrun[qb] = -1e29f; lrun[qb] = 0.f; }
    constexpr bool SPLIT = (KCH + VCH <= 512);
    u32x4 kreg[3], vreg[SPLIT ? 1 : 3];
    const int Tl = T1 - 1;
    const bool isv = SPLIT && tid >= KCH; const int vi = SPLIT ? tid - KCH : tid;
    const bf16* kp_ = isv ? Vg + vi * 8 : Kg + tid * 8; const bf16* vp_ = Vg + vi * 8;
    const int kdst = isv ? 2 * KBYTES + (vi >> 2) * VSTR + (vi & 3) * 16 : (tid / CPR) * KSTR + (tid % CPR) * 16, kbuf = isv ? VBYTES : KBYTES;
    const int vdst = 2 * KBYTES + (vi >> 2) * VSTR + (vi & 3) * 16;
#pragma unroll
    for (int u = 0; u < 3; ++u) { const int Tc = (T0 + u < Tl) ? T0 + u : Tl; kreg[u] = *(const u32x4*)(kp_ + (size_t)Tc * 32 * HD); if constexpr (!SPLIT) vreg[u] = *(const u32x4*)(vp_ + (size_t)Tc * HD * 32); }
    for (int Tb = T0; Tb < T1; Tb += 3) {
#pragma unroll
      for (int u = 0; u < 3; ++u) { const int T = Tb + u;
        *(LAS u32x4*)(lds + kdst + (T & 1) * kbuf) = kreg[u];
        if constexpr (!SPLIT) *(LAS u32x4*)(lds + vdst + (T & 1) * VBYTES) = vreg[u];
        __syncthreads();
        { const int Tc = (T + 3 < Tl) ? T + 3 : Tl; kreg[u] = *(const u32x4*)(kp_ + (size_t)Tc * 32 * HD); if constexpr (!SPLIT) vreg[u] = *(const u32x4*)(vp_ + (size_t)Tc * HD * 32); }
        if (T < T1) {
        const LAS unsigned char* kb = KB + (T & 1) * KBYTES + r32 * KSTR + h * 16;
        const LAS unsigned char* vb = VB + (T & 1) * VBYTES + r32 * VSTR + h * 16;
        const bool inter = mask.interior(T);
#pragma unroll
        for (int qb = 0; qb < NQB; ++qb) {
            const bool unset = mrun[qb] <= -1e29f;
            const float cb = unset ? 0.f : -mrun[qb];
            f32x16 p = (f32x16){cb,cb,cb,cb,cb,cb,cb,cb,cb,cb,cb,cb,cb,cb,cb,cb};
#pragma unroll
            for (int s = 0; s < HD / 16; ++s) { const bf16x8 kf = *(const LAS bf16x8*)(kb + s * 32);
                p = __builtin_amdgcn_mfma_f32_32x32x16_bf16(kf, Qf[qb][s], p, 0, 0, 0); }
            if (!inter) {
#pragma unroll
                for (int r = 0; r < 16; ++r) p[r] = mask(T, krow(r, h), qb) ? p[r] : -1e30f;
            }
            float lm = fmaxf(fmaxf(p[0], p[1]), fmaxf(p[2], p[3]));
#pragma unroll
            for (int r = 4; r < 16; r += 4) lm = fmaxf(lm, fmaxf(fmaxf(p[r], p[r + 1]), fmaxf(p[r + 2], p[r + 3])));
            if (__any(lm > 8.0f || (unset && lm > -1e29f))) {
                const float cm = fmaxf(lm, __shfl_xor(lm, 32));
                const bool valid = cm > -1e29f;
                const float d = unset ? (valid ? cm : 0.f) : fmaxf(cm, 0.f);
                const float alpha = unset ? 1.f : __builtin_amdgcn_exp2f(-d);
                mrun[qb] = unset ? (valid ? cm : mrun[qb]) : mrun[qb] + d;
                lrun[qb] *= alpha;
#pragma unroll
                for (int r = 0; r < 16; ++r) p[r] -= d;
#pragma unroll
                for (int db = 0; db < HD / 32; ++db) O[db][qb] = O[db][qb] * alpha;
            }
            float s0 = 0.f, s1 = 0.f, s2 = 0.f, s3 = 0.f;
#pragma unroll
            for (int r = 0; r < 16; r += 4) { p[r] = __builtin_amdgcn_exp2f(p[r]); p[r + 1] = __builtin_amdgcn_exp2f(p[r + 1]); p[r + 2] = __builtin_amdgcn_exp2f(p[r + 2]); p[r + 3] = __builtin_amdgcn_exp2f(p[r + 3]);
                s0 += p[r]; s1 += p[r + 1]; s2 += p[r + 2]; s3 += p[r + 3]; }
            lrun[qb] += (s0 + s1) + (s2 + s3);
            bf16x8 Pf[2];
#pragma unroll
            for (int s2_ = 0; s2_ < 2; ++s2_) { u32x4 w; w.x = cvtpk(p[8 * s2_], p[8 * s2_ + 1]); w.y = cvtpk(p[8 * s2_ + 2], p[8 * s2_ + 3]);
                w.z = cvtpk(p[8 * s2_ + 4], p[8 * s2_ + 5]); w.w = cvtpk(p[8 * s2_ + 6], p[8 * s2_ + 7]); Pf[s2_] = __builtin_bit_cast(bf16x8, w); }
#pragma unroll
            for (int db = 0; db < HD / 32; ++db)
#pragma unroll
                for (int s2_ = 0; s2_ < 2; ++s2_) { const bf16x8 vf = *(const LAS bf16x8*)(vb + db * 32 * VSTR + s2_ * 32);
                    O[db][qb] = __builtin_amdgcn_mfma_f32_32x32x16_bf16(vf, Pf[s2_], O[db][qb], 0, 0, 0); }
        }
      } }
    }
#pragma unroll
    for (int qb = 0; qb < NQB; ++qb) Lout[qb] = lrun[qb] + __shfl_xor(lrun[qb], 32);
    __syncthreads();
}

__device__ __forceinline__ void nsa_unit(Frame& F, int b, int g, int c, const bf16* q, const float* gnsa, const bf16* kc, const bf16* vct,
                                         const bf16* kvs, bf16* acat) {
    LAS unsigned char* lds = F.lds;
    int tid = F.tid; asm volatile("" : "+v"(tid));
    const int lane = tid & 63, w = F.wave, r32 = lane & 31, h = lane >> 5;
    LAS unsigned* imp = (LAS unsigned*)(lds + L_IMP);
    LAS unsigned char* yt = lds + L_YT;
    const int bg = b * 2 + g, head = 8 * g + w;
    const size_t rowbase = (size_t)b * SEQ + 64 * c;
    for (int i = tid; i < 64 * IMP_STRIDE; i += 512) imp[i] = 0u;
    bf16x8 Qf[2][4]; float g0[2], g2[2]; int tq[2];
#pragma unroll
    for (int qb = 0; qb < 2; ++qb) {
        const size_t row = rowbase + 32 * qb + r32; tq[qb] = 64 * c + 32 * qb + r32;
#pragma unroll
        for (int s = 0; s < 4; ++s) Qf[qb][s] = *(const bf16x8*)(q + row * 1024 + head * 64 + 16 * s + 8 * h);
        g0[qb] = gnsa[row * 48 + head * 3 + 0]; g2[qb] = gnsa[row * 48 + head * 3 + 2];
    }
    f32x16 O[2][2];
#pragma unroll
    for (int db = 0; db < 2; ++db)
#pragma unroll
        for (int qb = 0; qb < 2; ++qb) O[db][qb] = (f32x16){0.f,0.f,0.f,0.f,0.f,0.f,0.f,0.f,0.f,0.f,0.f,0.f,0.f,0.f,0.f,0.f};
    __syncthreads();
#ifndef NO_WIN
    { MaskWin mk; mk.tq[0] = tq[0]; mk.tq[1] = tq[1]; mk.base = 64 * c - 512;
      const int T0 = (16 - 2 * c) > 0 ? (16 - 2 * c) : 0;
      const bf16* kw = kvs + 4 * KVSLAB + ((size_t)bg * 8192 + 64 * c - 512) * 64;
      const bf16* vw = kvs + 5 * KVSLAB + ((size_t)bg * 256 + 2 * c - 16) * 2048;
      float Lw[2];
      attn1pass<64, 2>(lds, kw, vw, T0, 18, Qf, mk, O, Lw, tid, lane);
#if (P3REP & 4)
      { f32x16 Od[2][2]; float Ld[2];
#pragma unroll
        for (int db = 0; db < 2; ++db)
#pragma unroll
            for (int qb = 0; qb < 2; ++qb) Od[db][qb] = (f32x16){0.f,0.f,0.f,0.f,0.f,0.f,0.f,0.f,0.f,0.f,0.f,0.f,0.f,0.f,0.f,0.f};
        attn1pass<64, 2>(lds, kw, vw, T0, 18, Qf, mk, Od, Ld, tid, lane);
        asm volatile("" :: "v"(Od[0][0]), "v"(Od[0][1]), "v"(Od[1][0]), "v"(Od[1][1]), "v"(Ld[0]), "v"(Ld[1])); }
#endif
#pragma unroll
      for (int qb = 0; qb < 2; ++qb) { const float sc = Lw[qb] > 0.f ? g2[qb] / Lw[qb] : 0.f;
#pragma unroll
          for (int db = 0; db < 2; ++db) O[db][qb] = O[db][qb] * sc; }
    }
#endif
#ifndef NO_CMP
    { MaskCmp mk; mk.tq[0] = tq[0]; mk.tq[1] = tq[1];
      const int NT = (4 * c + 2) / 32 + 1;
      attn2pass<64, 2, true>(lds, kc + (size_t)bg * 512 * 64, vct + (size_t)bg * 16 * 2048, 0, NT, Qf, mk, g0, O, imp, tid, lane);
#if (P3REP & 1)
      { float z0 = 0.f; asm volatile("" : "+v"(z0)); const float gz[2] = {z0, z0};
        attn2pass<64, 2, true>(lds, kc + (size_t)bg * 512 * 64, vct + (size_t)bg * 16 * 2048, 0, NT, Qf, mk, gz, O, imp, tid, lane); }
#endif
    }
#endif
#ifndef NO_TOPK
    for (int rp_ = 0; rp_ < ((P3REP & 2) ? 2 : 1); ++rp_)
    for (int qi = 0; qi < 8; ++qi) {
        const int ql = 8 * w + qi;
        unsigned long long blo, bhi;
        if (c < 16) { blo = (2ull << c) - 1ull; bhi = 0ull; }
        else {
            const int hi = c - 2;
            const int j0 = 1 + lane, j1 = 65 + lane;
            const bool ok0 = j0 <= hi, ok1 = j1 <= hi;
            const unsigned v0 = ok0 ? imp[ql * IMP_STRIDE + j0] : 0u, v1 = ok1 ? imp[ql * IMP_STRIDE + j1] : 0u;
            unsigned T = 0u;
            for (int bit = 30; bit >= 0; --bit) { const unsigned cand = T | (1u << bit);
                const int cnt = __popcll(__ballot(v0 >= cand)) + __popcll(__ballot(v1 >= cand));
                if (cnt >= 13) T = cand; }
            const unsigned long long gt0 = __ballot(ok0 && v0 > T), gt1 = __ballot(ok1 && v1 > T);
            const unsigned long long eq0 = __ballot(ok0 && v0 == T), eq1 = __ballot(ok1 && v1 == T);
            const int need = 13 - __popcll(gt0) - __popcll(gt1);
            const unsigned long long lt = (1ull << lane) - 1ull;
            const bool t0 = ok0 && v0 == T && __popcll(eq0 & lt) < need, t1 = ok1 && v1 == T && (__popcll(eq0) + __popcll(eq1 & lt)) < need;
            const unsigned long long m0 = gt0 | __ballot(t0), m1 = gt1 | __ballot(t1);
            blo = (m0 << 1) | 1ull; bhi = (m1 << 1) | (m0 >> 63);
            if (c - 1 < 64) blo |= 1ull << (c - 1); else bhi |= 1ull << (c - 65);
            if (c < 64) blo |= 1ull << c; else bhi |= 1ull << (c - 64);
        }
        if (lane == 0) { LAS unsigned long long* sb = (LAS unsigned long long*)(lds + L_SEL) + ql * 2; sb[0] = blo; sb[1] = bhi; }
    }
#endif
#pragma unroll
    for (int db = 0; db < 2; ++db)
#pragma unroll
        for (int qb = 0; qb < 2; ++qb)
#pragma unroll
            for (int a = 0; a < 4; ++a) {
                u32x2 wv; wv.x = cvtpk(O[db][qb][4 * a], O[db][qb][4 * a + 1]); wv.y = cvtpk(O[db][qb][4 * a + 2], O[db][qb][4 * a + 3]);
                *(LAS u32x2*)(yt + (32 * qb + r32) * YT_STRIDE + (w * 64 + 32 * db + 8 * a + 4 * h) * 2) = wv;
            }
    __syncthreads();
#ifndef NO_SEL
    {
        int tid_o = tid; asm volatile("" : "+v"(tid_o));
        const int lane_o = tid_o & 63, n16 = lane_o & 15, kq = lane_o >> 4, qh = n16 >> 3;
        constexpr int SROW = 144, SKB = 64 * SROW, SBUF = 2 * SKB;
        const bf16* ksb = kvs + 2 * KVSLAB + (size_t)bg * 8192 * 64;
        const bf16* vsb = kvs + 3 * KVSLAB + (size_t)bg * 128 * 4096;
        for (int rp_ = 0; rp_ < ((P3REP & 8) ? 2 : 1); ++rp_) {
        float scm = (rp_ == 0) ? 1.f : 0.f; asm volatile("" : "+v"(scm));
        bf16x8 Qp[4][2]; float mrun[4], lrun[4]; f32x4 Os[4][4];
#pragma unroll
        for (int pp = 0; pp < 4; ++pp) {
            const size_t row = rowbase + 8 * w + 2 * pp + qh;
#pragma unroll
            for (int s = 0; s < 2; ++s) Qp[pp][s] = *(const bf16x8*)(q + row * 1024 + (8 * g + (n16 & 7)) * 64 + 32 * s + 8 * kq);
            mrun[pp] = 0.f; lrun[pp] = 0.f;
#pragma unroll
            for (int dt = 0; dt < 4; ++dt) Os[pp][dt] = (f32x4){0.f, 0.f, 0.f, 0.f};
        }
        unsigned long long mylo = 0ull, myhi = 0ull;
        if (lane_o < 8) { const LAS unsigned long long* sb = (const LAS unsigned long long*)(lds + L_SEL) + (8 * w + lane_o) * 2; mylo = sb[0]; myhi = sb[1]; }
        const int srow = tid_o >> 3, sch = tid_o & 7;
        constexpr int GB = 2, BLKB = 2 * SKB, SBUF2 = GB * BLKB;
        const int nint = (c + GB) / GB;
        u32x4 kreg[GB], vreg[GB];
#pragma unroll
        for (int gi = 0; gi < GB; ++gi) { const int jc = gi < c ? gi : c;
            kreg[gi] = *(const u32x4*)(ksb + (size_t)jc * 4096 + srow * 64 + sch * 8); vreg[gi] = *(const u32x4*)(vsb + (size_t)jc * 4096 + srow * 64 + sch * 8); }
        for (int it = 0; it < nint; ++it) {
            LAS unsigned char* stg = lds + (it & 1) * SBUF2;
#pragma unroll
            for (int gi = 0; gi < GB; ++gi) { *(LAS u32x4*)(stg + gi * BLKB + srow * SROW + sch * 16) = kreg[gi]; *(LAS u32x4*)(stg + gi * BLKB + SKB + srow * SROW + sch * 16) = vreg[gi]; }
            __syncthreads();
#pragma unroll
            for (int gi = 0; gi < GB; ++gi) { const int jn = (it + 1) * GB + gi, jc = jn < c ? jn : c;
                kreg[gi] = *(const u32x4*)(ksb + (size_t)jc * 4096 + srow * 64 + sch * 8); vreg[gi] = *(const u32x4*)(vsb + (size_t)jc * 4096 + srow * 64 + sch * 8); }
#pragma unroll
            for (int gi = 0; gi < GB; ++gi) {
            const int j = it * GB + gi;
            const unsigned act = (j <= c) ? ((unsigned)__ballot((((j < 64 ? mylo : myhi) >> (j & 63)) & 1ull) != 0ull) & 0xffu) : 0u;
            if (act != 0u) {
            const LAS unsigned char* kfp = stg + gi * BLKB + n16 * SROW + kq * 16; const LAS unsigned char* vfp = kfp + SKB;
            bf16x8 kf[4][2], vf[4][2];
#pragma unroll
            for (int kt = 0; kt < 4; ++kt) { kf[kt][0] = *(const LAS bf16x8*)(kfp + kt * 16 * SROW); kf[kt][1] = *(const LAS bf16x8*)(kfp + kt * 16 * SROW + 64); }
#pragma unroll
            for (int dt = 0; dt < 4; ++dt) { vf[dt][0] = *(const LAS bf16x8*)(vfp + dt * 16 * SROW); vf[dt][1] = *(const LAS bf16x8*)(vfp + dt * 16 * SROW + 64); }
#pragma unroll
            for (int pp = 0; pp < 4; ++pp) {
                if (((act >> (2 * pp)) & 3u) == 0u) continue;
                const bool colsel = ((act >> (2 * pp + qh)) & 1u) != 0u;
                const float cb = colsel ? -mrun[pp] : -1e30f;
                f32x4 S[4];
#pragma unroll
                for (int kt = 0; kt < 4; ++kt) S[kt] = __builtin_amdgcn_mfma_f32_16x16x32_bf16(kf[kt][0], Qp[pp][0], (f32x4){cb, cb, cb, cb}, 0, 0, 0);
#pragma unroll
                for (int kt = 0; kt < 4; ++kt) S[kt] = __builtin_amdgcn_mfma_f32_16x16x32_bf16(kf[kt][1], Qp[pp][1], S[kt], 0, 0, 0);
                if (j == c) {
                    const int lim = 8 * w + 2 * pp + qh - 4 * kq;
#pragma unroll
                    for (int kt = 0; kt < 4; ++kt)
#pragma unroll
                        for (int r = 0; r < 4; ++r) S[kt][r] = (16 * kt + r <= lim) ? S[kt][r] : -1e30f;
                }
                float lm = fmaxf(fmaxf(S[0][0], S[0][1]), fmaxf(S[0][2], S[0][3]));
#pragma unroll
                for (int kt = 1; kt < 4; ++kt) lm = fmaxf(lm, fmaxf(fmaxf(S[kt][0], S[kt][1]), fmaxf(S[kt][2], S[kt][3])));
                if (j == 0 || __any(lm > 8.0f)) {
                    float cm = fmaxf(lm, __shfl_xor(lm, 16)); cm = fmaxf(cm, __shfl_xor(cm, 32));
                    const float d = (j == 0) ? cm : fmaxf(cm, 0.f);
                    const float alpha = __builtin_amdgcn_exp2f(-d);
                    mrun[pp] += d; lrun[pp] *= alpha;
#pragma unroll
                    for (int kt = 0; kt < 4; ++kt) S[kt] = S[kt] - d;
#pragma unroll
                    for (int dt = 0; dt < 4; ++dt) Os[pp][dt] = Os[pp][dt] * alpha;
                }
                float sum = 0.f;
#pragma unroll
                for (int kt = 0; kt < 4; ++kt)
#pragma unroll
                    for (int r = 0; r < 4; ++r) { const float p = __builtin_amdgcn_exp2f(S[kt][r]); S[kt][r] = p; sum += p; }
                lrun[pp] += sum;
                bf16x8 Pb[2];
#pragma unroll
                for (int s = 0; s < 2; ++s) { u32x4 wv; wv.x = cvtpk(S[2 * s][0], S[2 * s][1]); wv.y = cvtpk(S[2 * s][2], S[2 * s][3]);
                    wv.z = cvtpk(S[2 * s + 1][0], S[2 * s + 1][1]); wv.w = cvtpk(S[2 * s + 1][2], S[2 * s + 1][3]); Pb[s] = __builtin_bit_cast(bf16x8, wv); }
#pragma unroll
                for (int dt = 0; dt < 4; ++dt) Os[pp][dt] = __builtin_amdgcn_mfma_f32_16x16x32_bf16(vf[dt][0], Pb[0], Os[pp][dt], 0, 0, 0);
#pragma unroll
                for (int dt = 0; dt < 4; ++dt) Os[pp][dt] = __builtin_amdgcn_mfma_f32_16x16x32_bf16(vf[dt][1], Pb[1], Os[pp][dt], 0, 0, 0);
            }
            }
            }
        }
#pragma unroll
        for (int pp = 0; pp < 4; ++pp) {
            float L = lrun[pp]; L += __shfl_xor(L, 16); L += __shfl_xor(L, 32);
            const int ql = 8 * w + 2 * pp + qh;
            const float sc = (L > 0.f ? 1.0f / L : 0.f) * gnsa[(rowbase + ql) * 48 + (8 * g + (n16 & 7)) * 3 + 1] * scm;
#pragma unroll
            for (int dt = 0; dt < 4; ++dt) {
                LAS u32x2* yp = (LAS u32x2*)(yt + ql * YT_STRIDE + ((n16 & 7) * 64 + 16 * dt + 4 * kq) * 2);
                const u32x2 old = *yp; u32x2 nw;
                nw.x = cvtpk(bflo(old.x) + Os[pp][dt][0] * sc, bfhi(old.x) + Os[pp][dt][1] * sc);
                nw.y = cvtpk(bflo(old.y) + Os[pp][dt][2] * sc, bfhi(old.y) + Os[pp][dt][3] * sc);
                *yp = nw;
            }
        }
        __syncthreads();
        }
    }
#endif
    __syncthreads();
#pragma unroll
    for (int i = 0; i < 8; ++i) { const int idx = tid + 512 * i, rr = idx >> 6, ch = idx & 63;
        const u32x4 v = *(const LAS u32x4*)(yt + rr * YT_STRIDE + ch * 16);
        *(u32x4*)(acat + (rowbase + rr) * 2048 + 512 + g * 512 + ch * 8) = v; }
    __syncthreads();
}

__device__ __forceinline__ void mem_unit(Frame& F, int b, int head, int chunk, const bf16* qx, const bf16* mk, const bf16* mvt, bf16* acat) {
    int lane = F.lane; asm volatile("" : "+v"(lane));
    const int r32 = lane & 31, h = lane >> 5;
    const size_t row = (size_t)b * SEQ + 256 * chunk + 32 * F.wave + r32;
    bf16x8 Qf[1][8];
#pragma unroll
    for (int s = 0; s < 8; ++s) Qf[0][s] = *(const bf16x8*)(qx + row * 512 + head * 128 + 16 * s + 8 * h);
    f32x16 O[4][1];
#pragma unroll
    for (int db = 0; db < 4; ++db) O[db][0] = (f32x16){0.f,0.f,0.f,0.f,0.f,0.f,0.f,0.f,0.f,0.f,0.f,0.f,0.f,0.f,0.f,0.f};
    MaskNone mk0; float Lm[1];
    attn1pass<128, 1>(F.lds, mk + (size_t)(b * 4 + head) * 256 * 128, mvt + (size_t)(b * 4 + head) * 8 * 4096, 0, 8, Qf, mk0, O, Lm, F.tid, lane);
    { const float sc = Lm[0] > 0.f ? 1.0f / Lm[0] : 0.f;
#pragma unroll
      for (int db = 0; db < 4; ++db) O[db][0] = O[db][0] * sc; }
#pragma unroll
    for (int db = 0; db < 4; ++db)
#pragma unroll
        for (int a = 0; a < 4; ++a) {
            u32x2 wv; wv.x = cvtpk(O[db][0][4 * a], O[db][0][4 * a + 1]); wv.y = cvtpk(O[db][0][4 * a + 2], O[db][0][4 * a + 3]);
            *(u32x2*)(acat + row * 2048 + 1536 + head * 128 + 32 * db + 8 * a + 4 * h) = wv;
        }
}

constexpr int NPHASE = 11;
__global__ void __launch_bounds__(512, 2) mk_fwd(Args args) {
    extern __shared__ __attribute__((aligned(16))) unsigned char lds_raw[];
    Frame F;
    F.lds = (LAS unsigned char*)lds_raw;
    F.tid = threadIdx.x; F.lane = F.tid & 63; F.wave = __builtin_amdgcn_readfirstlane(F.tid >> 6);
    F.G = gridDim.x; F.bx = blockIdx.x; F.vcu = (F.G % 8 == 0) ? (F.bx % 8) * (F.G / 8) + F.bx / 8 : F.bx;
    unsigned char* ws = args.ws;
    gu32* ctl = (gu32*)(ws + WS_CTL);
    volatile LAS unsigned* MISC = (volatile LAS unsigned*)(F.lds + MISC_OFF);
    for (int u = F.tid; u < (LDS_BYTES - LDSCTL_OFF) / 4; u += 512) ((LAS unsigned*)(F.lds + LDSCTL_OFF))[u] = 0u;
    __syncthreads();
#if MK_LAUNCHES == 1
    XcdBarrier bar = xcd_barrier_post((unsigned*)(ctl + CW_BAR), MISC + 8);
#define GRID_BAR() xcd_barrier(bar)
#else
#define GRID_BAR() do {} while (0)
#endif
    const int lo = args.ph_lo, hi = args.ph_hi;
#ifndef PH_MASK
#define PH_MASK 0x7ff
#endif
#define IN(k) ((((PH_MASK) >> (k)) & 1) && lo <= (k) && (k) < hi)
#ifndef REPEAT_MASK
#define REPEAT_MASK 0
#endif
#define NREP(k) ((((REPEAT_MASK) >> (k)) & 1) ? 2 : 1)
#define SEAM(k) do { if (IN(k) && IN((k) + 1)) GRID_BAR(); } while (0)
    const float* x = args.in[0]; const float* mem = args.in[1]; const int* positions = (const int*)args.in[2];
    const float* pre_mix_g = args.in[3]; const float* w_in = args.in[4]; const float* pool_w = args.in[5]; const float* pool_scale = args.in[6];
    const float* cmp_pe = args.in[7]; const float* cmp_w1 = args.in[8]; const float* cmp_w2 = args.in[9]; const float* mem_norm_g = args.in[10];
    const float* w_mem_kv = args.in[11]; const float* w_br_pool = args.in[12]; const float* w_br_nsa = args.in[13]; const float* w_br_xa = args.in[14];
    const float* w_out = args.in[15]; const float* post_mix_g = args.in[16]; const float* pre_ffn_g = args.in[17]; const float* w_up = args.in[18];
    const float* conv_w = args.in[19]; const float* conv_b = args.in[20]; const float* w_down = args.in[21]; const float* post_ffn_g = args.in[22];
    float* out = args.out;
    bf16* q_buf = (bf16*)out; bf16* qx_buf = (bf16*)((char*)out + 32 * MiB); bf16* upool = (bf16*)((char*)out + 48 * MiB);
    float* rope = (float*)(ws + WS_ROPE); float* bias1 = (float*)(ws + WS_BIAS1); float* b1part = (float*)(ws + WS_B1PART);
    bf16* wc2t = (bf16*)(ws + WS_WC2T); bf16* kc = (bf16*)(ws + WS_KC); bf16* vct = (bf16*)(ws + WS_VCT);
    bf16* memn = (bf16*)(ws + WS_MEMN); bf16* memk = (bf16*)(ws + WS_MEMK); bf16* memvt = (bf16*)(ws + WS_MEMVT);
    bf16* hid = (bf16*)(ws + WS_HID); float* gnsa = (float*)(ws + WS_GNSA);
    bf16* wcat = (bf16*)(ws + WS_WCAT); bf16* wout_t = (bf16*)(ws + WS_WOUT); bf16* wup_t = (bf16*)(ws + WS_WUP); bf16* wdown_t = (bf16*)(ws + WS_WDOWN);
    bf16* wmem_t = (bf16*)(ws + WS_WMEM); bf16* wc1_t = (bf16*)(ws + WS_WC1); bf16* win_t = (bf16*)(ws + WS_WIN);
    bf16* kvs = (bf16*)(ws + WS_KV); bf16* ybuf = (bf16*)(ws + WS_Y); float* fbuf = (float*)(ws + WS_F);
    bf16* acat = (bf16*)(ws + WS_ACAT); bf16* hbuf = (bf16*)(ws + WS_ACAT); bf16* gbr = (bf16*)(ws + WS_GBR); bf16* a2 = (bf16*)(ws + WS_A2); bf16* halo = (bf16*)(ws + WS_HALO);
    const int gw = F.vcu * 8 + F.wave, NGW = F.G * 8;
    const int gt = F.vcu * 512 + F.tid, NGT = F.G * 512;

    for (int rep_ = 0; rep_ < NREP(0); ++rep_) { if (rep_) GRID_BAR();
    if (IN(0)) {
        LAS float* scr = (LAS float*)(F.lds + F.wave * 16384);
        constexpr int I_IN = 16 * 192, I_UP = 16 * 176, I_DN = 44 * 32, I_NSA = 16 * 32, I_XA = 8 * 32, I_OUT = 16 * 32, I_MEM = 16 * 32, I_C1 = 32 * 8, I_C2 = 4 * 2;
        constexpr int NITEMS = I_IN + I_UP + I_DN + I_NSA + I_XA + I_OUT + I_MEM + 2 * I_C1 + 2 * I_C2;
        for (int it = gw; it < NITEMS; it += NGW) {
            int r = it;
            if (r < I_IN) { transpose_item(w_in, DIN, win_t, 1024, 0, scr, 192, r, F.lane, MapIn()); continue; } r -= I_IN;
            if (r < I_UP) { transpose_item(w_up, DFF2, wup_t, 1024, 0, scr, 176, r, F.lane, MapUp()); continue; } r -= I_UP;
            if (r < I_DN) { transpose_item(w_down, 1024, wdown_t, DFF, 0, scr, 32, r, F.lane, MapId()); continue; } r -= I_DN;
            if (r < I_NSA) { transpose_item(w_br_nsa, 1024, wcat, 2048, 512, scr, 32, r, F.lane, MapId()); continue; } r -= I_NSA;
            if (r < I_XA) { transpose_item(w_br_xa, 1024, wcat, 2048, 1536, scr, 32, r, F.lane, MapId()); continue; } r -= I_XA;
            if (r < I_OUT) { transpose_item(w_out, 1024, wout_t, 1024, 0, scr, 32, r, F.lane, MapId()); continue; } r -= I_OUT;
            if (r < I_MEM) { transpose_item(w_mem_kv, 1024, wmem_t, 1024, 0, scr, 32, r, F.lane, MapId()); continue; } r -= I_MEM;
            if (r < 2 * I_C1) { const int z = r / I_C1; transpose_item(cmp_w1 + (size_t)z * 2048 * 256, 256, wc1_t + (size_t)z * 256 * 2048, 2048, 0, scr, 8, r % I_C1, F.lane, MapId()); continue; } r -= 2 * I_C1;
            { const int z = r / I_C2; transpose_item(cmp_w2 + (size_t)z * 256 * 64, 64, wc2t + (size_t)z * 64 * 256, 256, 0, scr, 2, r % I_C2, F.lane, MapId()); }
        }
        for (int m = gw; m < MTOK + 512; m += NGW) {
            if (m < MTOK) rms_row_to_bf16(x + (size_t)m * DM, pre_mix_g, hbuf + (size_t)m * DM, F.lane);
            else rms_row_to_bf16(mem + (size_t)(m - MTOK) * DM, mem_norm_g, memn + (size_t)(m - MTOK) * DM, F.lane);
        }
        for (int i = gt; i < MTOK * 8; i += NGT) { const int row = i >> 3, k = i & 7; const float ang = (float)positions[row] * args.invf[k];
            rope[(size_t)row * 16 + k] = cosf(ang); rope[(size_t)row * 16 + 8 + k] = sinf(ang); }
        for (int tsk = gw; tsk < 2 * 16 * 4; tsk += NGW) { const int z = tsk >> 6, kcn = (tsk >> 2) & 15, nb = tsk & 3, n = nb * 64 + F.lane;
            const float* pe = cmp_pe + (size_t)z * 2048 + kcn * 128; const float* w1 = cmp_w1 + ((size_t)z * 2048 + kcn * 128) * 256 + n; float s = 0.f;
#pragma unroll 8
            for (int k = 0; k < 128; ++k) s += pe[k] * w1[(size_t)k * 256];
            b1part[(z * 16 + kcn) * 256 + n] = s; }
        for (int tsk = gw; tsk < 64 * 16; tsk += NGW) { const int k8 = tsk >> 4, nb = tsk & 15, n = nb * 64 + F.lane, gi = k8 >> 4, cc0 = (k8 & 15) * 8;
            float accw[8];
#pragma unroll
            for (int j = 0; j < 8; ++j) accw[j] = 0.f;
            for (int d = 0; d < 128; ++d) { const float wv = pool_scale[gi * 128 + d] * w_br_pool[(size_t)(gi * 128 + d) * 1024 + n];
#pragma unroll
                for (int j = 0; j < 8; ++j) accw[j] += pool_w[((size_t)gi * 128 + cc0 + j) * 128 + d] * wv; }
            u32x4 o; o.x = cvtpk(accw[0], accw[1]); o.y = cvtpk(accw[2], accw[3]); o.z = cvtpk(accw[4], accw[5]); o.w = cvtpk(accw[6], accw[7]);
            *(u32x4*)(wcat + (size_t)n * 2048 + gi * 128 + cc0) = o; }
    }
    }
    SEAM(0);

    for (int rep_ = 0; rep_ < NREP(1); ++rep_) { if (rep_) GRID_BAR();
    if (IN(1)) {
        if (F.bx == 0) { const int z = F.tid >> 8, n = F.tid & 255; float s = 0.f;
#pragma unroll
            for (int k = 0; k < 16; ++k) s += b1part[(z * 16 + k) * 256 + n];
            bias1[z * 256 + n] = s; }
        pg8::Gemm g{hbuf, win_t, 1024, 1024}; pg8::SchedGrid S{64, 24, F.G, F.bx, 16};
        pg8::EpiIn E{upool, q_buf, qx_buf, gbr, gnsa, kvs, rope};
        pg8::gemm_phase<pg8::EpiIn, pg8::SchedGrid, true>(F.lds, g, S, E);
    }
    }
    SEAM(1);

    for (int rep_ = 0; rep_ < NREP(2); ++rep_) { if (rep_) GRID_BAR();
    if (IN(2)) {
        if (F.bx < 16) {
            pg8::Gemm g{kvs, wc1_t, 1024, 2048}; pg8::SchedCmp S{16, F.bx};
            pg8::EpiCmp E{hid, bias1};
            pg8::gemm_phase<pg8::EpiCmp, pg8::SchedCmp, true>(F.lds, g, S, E);
            VM_WAIT(); __syncthreads();
            const int z = F.bx >> 3, R0 = F.bx * 256 + 32 * F.wave, r32 = F.lane & 31, h = F.lane >> 5;
            f32x16 C[2]; C[0] = (f32x16){0.f,0.f,0.f,0.f,0.f,0.f,0.f,0.f,0.f,0.f,0.f,0.f,0.f,0.f,0.f,0.f}; C[1] = C[0];
#pragma unroll 4
            for (int s = 0; s < 16; ++s) {
                const bf16x8 af = *(const bf16x8*)(hid + (size_t)(R0 + r32) * 256 + 16 * s + 8 * h);
#pragma unroll
                for (int nb = 0; nb < 2; ++nb) { const bf16x8 bfr = *(const bf16x8*)(wc2t + ((size_t)z * 64 + nb * 32 + r32) * 256 + 16 * s + 8 * h);
                    C[nb] = __builtin_amdgcn_mfma_f32_32x32x16_bf16(af, bfr, C[nb], 0, 0, 0); }
            }
#pragma unroll
            for (int nb = 0; nb < 2; ++nb)
#pragma unroll
                for (int r = 0; r < 16; ++r) {
                    const int R = R0 + krow(r, h), bgi = (R >> 9) & 3, i = R & 511, n = nb * 32 + r32;
                    if (z == 0) kc[((size_t)bgi * 512 + i) * 64 + n] = f2bf(C[nb][r]);
                    else { const int kk = i & 31, pos = (kk & 16) | (kk & 3) | (((kk >> 3) & 1) << 2) | (((kk >> 2) & 1) << 3);
                           vct[(((size_t)bgi * 16 + (i >> 5)) * 64 + n) * 32 + pos] = f2bf(C[nb][r]); }
                }
        } else if (F.bx < 24) {
            pg8::Gemm g{memn, wmem_t, 1024, 1024}; pg8::SchedGrid S{2, 4, 8, F.bx - 16, 16};
            pg8::EpiMemKV E{memk, memvt};
            pg8::gemm_phase<pg8::EpiMemKV, pg8::SchedGrid, true>(F.lds, g, S, E);
        } else {
            const int nthr = (F.G - 24) * 512;
            for (int i = (F.bx - 24) * 512 + F.tid; i < MTOK * 64; i += nthr) {
                const int row = i >> 6, o = i & 63, t = row & 8191, wsz = 2 << (o >> 4);
                const int cnt = (t + 1) < wsz ? (t + 1) : wsz;
                float s[8];
#pragma unroll
                for (int e = 0; e < 8; ++e) s[e] = 0.f;
                u32x4 cur = (u32x4){0u, 0u, 0u, 0u};
                for (int k = 0; k < cnt; ++k) { const u32x4 v = *(const u32x4*)(upool + (size_t)(row - k) * 512 + o * 8); if (k == 0) cur = v;
                    s[0] += bflo(v.x); s[1] += bfhi(v.x); s[2] += bflo(v.y); s[3] += bfhi(v.y); s[4] += bflo(v.z); s[5] += bfhi(v.z); s[6] += bflo(v.w); s[7] += bfhi(v.w); }
                const float ic = 1.0f / (float)cnt;
                u32x4 w; w.x = cvtpk(s[0] * ic - bflo(cur.x), s[1] * ic - bfhi(cur.x)); w.y = cvtpk(s[2] * ic - bflo(cur.y), s[3] * ic - bfhi(cur.y));
                w.z = cvtpk(s[4] * ic - bflo(cur.z), s[5] * ic - bfhi(cur.z)); w.w = cvtpk(s[6] * ic - bflo(cur.w), s[7] * ic - bfhi(cur.w));
                *(u32x4*)(acat + (size_t)row * 2048 + o * 8) = w;
            }
        }
    }
    }
    SEAM(2);

    for (int rep_ = 0; rep_ < NREP(3); ++rep_) { if (rep_) GRID_BAR();
    if (IN(3)) {
        for (int v = F.vcu; v < 256; v += F.G) {
            const int bg = v >> 6, pi = v & 63;
#ifndef NO_NSA
            for (int uu = 0; uu < 2; ++uu) nsa_unit(F, bg >> 1, bg & 1, uu ? 127 - pi : pi, q_buf, gnsa, kc, vct, kvs, acat);
#endif
#ifndef NO_MEM
            for (int rp_ = 0; rp_ < ((P3REP & 16) ? 2 : 1); ++rp_) mem_unit(F, v >> 7, (v >> 5) & 3, v & 31, qx_buf, memk, memvt, acat);
#endif
        }
    }
    }
    SEAM(3);

    for (int rep_ = 0; rep_ < NREP(4); ++rep_) { if (rep_) GRID_BAR();
    if (IN(4)) {
        pg8::Gemm g{acat, wcat, 2048, 2048}; pg8::SchedCat S{F.G, F.bx};
        pg8::EpiGate E{gbr, ybuf};
        pg8::gemm_phase<pg8::EpiGate, pg8::SchedCat, true>(F.lds, g, S, E);
    }
    }
    SEAM(4);

    for (int rep_ = 0; rep_ < NREP(5); ++rep_) { if (rep_) GRID_BAR();
    if (IN(5)) {
        pg8::Gemm g{ybuf, wout_t, 1024, 1024}; pg8::SchedGrid S{64, 4, F.G, F.bx, 16};
        pg8::EpiF32 E{out, 1024};
        pg8::gemm_phase<pg8::EpiF32, pg8::SchedGrid, true>(F.lds, g, S, E);
    }
    }
    SEAM(5);

    for (int rep_ = 0; rep_ < NREP(6); ++rep_) { if (rep_) GRID_BAR();
    if (IN(6)) {
        for (int m = gw; m < MTOK; m += NGW) {
            f32x4* yr = (f32x4*)(out + (size_t)m * DM) + F.lane; const f32x4* xr = (const f32x4*)(x + (size_t)m * DM) + F.lane;
            const f32x4* g1 = (const f32x4*)post_mix_g + F.lane; const f32x4* g2 = (const f32x4*)pre_ffn_g + F.lane;
            f32x4 v[4]; float s = 0.f;
#pragma unroll
            for (int j = 0; j < 4; ++j) { v[j] = yr[64 * j]; s += (v[j].x * v[j].x + v[j].y * v[j].y) + (v[j].z * v[j].z + v[j].w * v[j].w); }
            const float rstd = 1.0f / sqrtf(wave_sum(s) * (1.f / DM) + EPS); float s2 = 0.f;
#pragma unroll
            for (int j = 0; j < 4; ++j) { v[j] = xr[64 * j] + v[j] * rstd * g1[64 * j]; yr[64 * j] = v[j]; s2 += (v[j].x * v[j].x + v[j].y * v[j].y) + (v[j].z * v[j].z + v[j].w * v[j].w); }
            const float rstd2 = 1.0f / sqrtf(wave_sum(s2) * (1.f / DM) + EPS);
            u32x2* o8 = (u32x2*)(hbuf + (size_t)m * DM) + F.lane;
#pragma unroll
            for (int j = 0; j < 4; ++j) { const f32x4 gg = g2[64 * j]; u32x2 w; w.x = cvtpk(v[j].x * rstd2 * gg.x, v[j].y * rstd2 * gg.y); w.y = cvtpk(v[j].z * rstd2 * gg.z, v[j].w * rstd2 * gg.w); o8[64 * j] = w; }
        }
    }
    }
    SEAM(6);

    for (int rep_ = 0; rep_ < NREP(7); ++rep_) { if (rep_) GRID_BAR();
    if (IN(7)) {
        pg8::Gemm g{hbuf, wup_t, 1024, 1024}; pg8::SchedGrid S{64, 22, F.G, F.bx, 16};
        pg8::EpiConv E{a2, halo, conv_w, conv_b};
        pg8::gemm_phase<pg8::EpiConv, pg8::SchedGrid, true>(F.lds, g, S, E);
    }
    }
    SEAM(7);

    for (int rep_ = 0; rep_ < NREP(8); ++rep_) { if (rep_) GRID_BAR();
    if (IN(8)) {
        for (int i = gt; i < 256 * 2 * (DFF / 4); i += NGT) {
            const int c4 = i % (DFF / 4), rr = (i / (DFF / 4)) & 1, k = i / (2 * (DFF / 4)), ch = c4 * 4;
            const int gcol = 256 * (ch >> 7) + (ch & 127);
            const bool first = (k & 127) == 0;
            float cv[2][4];
#pragma unroll
            for (int bj = 0; bj < 2; ++bj) {
                const int ci = bj * DFF + ch; const bf16* hp = halo + (size_t)k * 4 * DFF2 + gcol + bj * 128;
                const f32x4 w0 = *(const f32x4*)(conv_w + ci), w1 = *(const f32x4*)(conv_w + DFF2 + ci), w2 = *(const f32x4*)(conv_w + 2 * DFF2 + ci), bb = *(const f32x4*)(conv_b + ci);
                u32x2 um2 = *(const u32x2*)(hp + (size_t)(rr + 0) * DFF2), um1 = *(const u32x2*)(hp + (size_t)(rr + 1) * DFF2), u0 = *(const u32x2*)(hp + (size_t)(rr + 2) * DFF2);
                if (first && rr == 0) { um2 = (u32x2){0u, 0u}; um1 = (u32x2){0u, 0u}; }
                if (first && rr == 1) { um2 = (u32x2){0u, 0u}; }
                cv[bj][0] = bb[0] + w0[0] * bflo(um2.x) + w1[0] * bflo(um1.x) + w2[0] * bflo(u0.x);
                cv[bj][1] = bb[1] + w0[1] * bfhi(um2.x) + w1[1] * bfhi(um1.x) + w2[1] * bfhi(u0.x);
                cv[bj][2] = bb[2] + w0[2] * bflo(um2.y) + w1[2] * bflo(um1.y) + w2[2] * bflo(u0.y);
                cv[bj][3] = bb[3] + w0[3] * bfhi(um2.y) + w1[3] * bfhi(um1.y) + w2[3] * bfhi(u0.y);
            }
            u32x2 w; w.x = cvtpk(gelu_tanh(cv[0][0]) * cv[1][0], gelu_tanh(cv[0][1]) * cv[1][1]); w.y = cvtpk(gelu_tanh(cv[0][2]) * cv[1][2], gelu_tanh(cv[0][3]) * cv[1][3]);
            *(u32x2*)(a2 + (size_t)(64 * k + rr) * DFF + ch) = w;
        }
    }
    }
    SEAM(8);

    for (int rep_ = 0; rep_ < NREP(9); ++rep_) { if (rep_) GRID_BAR();
    if (IN(9)) {
        pg8::Gemm g{a2, wdown_t, DFF, DFF}; pg8::SchedGrid S{64, 4, F.G, F.bx, 44};
        pg8::EpiF32 E{fbuf, 1024};
        pg8::gemm_phase<pg8::EpiF32, pg8::SchedGrid, true>(F.lds, g, S, E);
    }
    }
    SEAM(9);

    for (int rep_ = 0; rep_ < NREP(10); ++rep_) { if (rep_) GRID_BAR();
    if (IN(10)) {
        for (int m = gw; m < MTOK; m += NGW) {
            f32x4* orow = (f32x4*)(out + (size_t)m * DM) + F.lane; const f32x4* fr_ = (const f32x4*)(fbuf + (size_t)m * DM) + F.lane;
            const f32x4* g4 = (const f32x4*)post_ffn_g + F.lane;
            f32x4 v[4]; float s = 0.f;
#pragma unroll
            for (int j = 0; j < 4; ++j) { v[j] = fr_[64 * j]; s += (v[j].x * v[j].x + v[j].y * v[j].y) + (v[j].z * v[j].z + v[j].w * v[j].w); }
            const float rstd = 1.0f / sqrtf(wave_sum(s) * (1.f / DM) + EPS);
#pragma unroll
            for (int j = 0; j < 4; ++j) orow[64 * j] = orow[64 * j] + v[j] * rstd * g4[64 * j];
        }
    }
    }
#undef IN
#undef SEAM
}

extern "C" void kernel_launch(void* const* d_in, const int* in_sizes, int n_in, void* d_out, int out_size, void* d_ws, size_t ws_size, hipStream_t stream) {
    static int grid = 0;
    if (grid == 0) {
        if (n_in != 23 || in_sizes[0] != MTOK * DM || out_size != MTOK * DM || ws_size < WS_END) {
            fprintf(stderr, "kernel_launch: unexpected problem shape (n_in %d, in0 %d, out %d, ws %zu); nothing launched\n", n_in, n_in > 0 ? in_sizes[0] : -1, out_size, ws_size); grid = -1; return; }
        int dev = 0, cus = 0, per_cu = 0;
        if (hipGetDevice(&dev) != hipSuccess || hipDeviceGetAttribute(&cus, hipDeviceAttributeMultiprocessorCount, dev) != hipSuccess) { grid = -1; return; }
        if (hipFuncSetAttribute((const void*)mk_fwd, hipFuncAttributeMaxDynamicSharedMemorySize, LDS_BYTES) != hipSuccess) { fprintf(stderr, "kernel_launch: hipFuncSetAttribute failed\n"); grid = -1; return; }
        if (hipOccupancyMaxActiveBlocksPerMultiprocessor(&per_cu, (const void*)mk_fwd, 512, LDS_BYTES) != hipSuccess || per_cu < 1) {
            fprintf(stderr, "kernel_launch: occupancy query reports %d workgroups per CU; nothing launched\n", per_cu); (void)hipGetLastError(); grid = -1; return; }
        grid = cus;
    }
    if (grid < 0) return;
    (void)hipMemsetAsync((char*)d_ws + WS_CTL, 0, CTL_ZERO_BYTES, stream);
    Args a{};
    for (int i = 0; i < 23; ++i) a.in[i] = (const float*)d_in[i];
    a.out = (float*)d_out; a.ws = (unsigned char*)d_ws;
    for (int i = 0; i < 8; ++i) a.invf[i] = (float)pow(500000.0, -0.125 * (double)i);
#if MK_LAUNCHES == 1
    a.ph_lo = 0; a.ph_hi = NPHASE;
    hipLaunchKernelGGL(mk_fwd, dim3(grid), dim3(512), LDS_BYTES, stream, a);
#else
    for (int p = 0; p < NPHASE; ++p) { a.ph_lo = p; a.ph_hi = p + 1; hipLaunchKernelGGL(mk_fwd, dim3(grid), dim3(512), LDS_BYTES, stream, a); }
#endif
}
```
